# Optimizing an MI355X kernel written in HIP

```python
import math
import jax, jax.numpy as jnp
from jax import lax
import numpy as np

D_MODEL = 2048
BATCH = 1
SEQ = 8192
DEPTH = 4

BRANCH_WIDTH = D_MODEL // 2
N_BRANCHES = 3
MLSTM_HEADS = 4
MLSTM_HEAD_DIM = BRANCH_WIDTH // MLSTM_HEADS
MLSTM_CHUNK = 128
N_MLSTM_GATES = 2 * 2 * MLSTM_HEADS
HYENA_WIDTH = BRANCH_WIDTH
HYENA_BANDS = 16
HYENA_EMB = 2 * HYENA_BANDS + 1
HYENA_FILTER_HIDDEN = 64
S5_WIDTH = BRANCH_WIDTH
S5_GROUP = 16
S5_GROUPS = S5_WIDTH // S5_GROUP
S5_STATE = 64
PEER_HEADS = 8
PEER_KEYS = 128
PEER_TOPK = 16
PEER_QDIM = 256
PEER_HALF = PEER_QDIM // 2
N_EXPERTS = PEER_KEYS * PEER_KEYS
PEER_BLOCK = 128
IN_COLS = 4 * BRANCH_WIDTH + N_MLSTM_GATES + 3 * HYENA_WIDTH + S5_WIDTH + N_BRANCHES * D_MODEL
ALPHA = (2 * DEPTH) ** 0.25
BETA = (8 * DEPTH) ** -0.25
LN_EPS = 1e-5
F32 = jnp.float32

kernel_name = 'hybrid_mlstm_hyena_s5_peer_encoder'


def _layer_norm(x, g, b):
    xf = x.astype(F32)
    mu = xf.mean(-1, keepdims=True)
    var = jnp.square(xf - mu).mean(-1, keepdims=True)
    y = (xf - mu) * lax.rsqrt(var + LN_EPS)
    return (y * g.astype(F32) + b.astype(F32)).astype(x.dtype)


def _split_in(proj):
    sizes = (BRANCH_WIDTH,) * 4 + (N_MLSTM_GATES, 3 * HYENA_WIDTH, S5_WIDTH, N_BRANCHES * D_MODEL)
    idx = np.cumsum(sizes)[:-1].tolist()
    return jnp.split(proj, idx, axis=-1)


def _mlstm_chunk_step(carry, inp):
    c_state, n_state, m_state = carry
    q, k, v, log_i, log_f = inp
    L = q.shape[2]
    b = jnp.cumsum(log_f, axis=-1)
    tri = jnp.tril(jnp.ones((L, L), dtype=bool))
    log_d = jnp.where(tri, b[..., :, None] - b[..., None, :] + log_i[..., None, :], -jnp.inf)
    m_inter = b + m_state[..., None]
    m_t = jnp.maximum(m_inter, log_d.max(-1))
    inter = jnp.exp(m_inter - m_t)
    s = jnp.einsum('bhtd,bhsd->bhts', q, k) * jnp.exp(log_d - m_t[..., None])
    num = jnp.einsum('bhts,bhse->bhte', s, v) + inter[..., None] * jnp.einsum('bhtd,bhde->bhte', q, c_state)
    den = s.sum(-1) + inter * jnp.einsum('bhtd,bhd->bht', q, n_state)
    h = num / jnp.maximum(jnp.abs(den), jnp.exp(-m_t))[..., None]
    b_last = b[..., -1]
    log_w = b_last[..., None] - b + log_i
    m_new = jnp.maximum(b_last + m_state, log_w.max(-1))
    w = jnp.exp(log_w - m_new[..., None])
    decay = jnp.exp(b_last + m_state - m_new)
    c_new = decay[..., None, None] * c_state + jnp.einsum('bhs,bhsd,bhse->bhde', w, k, v)
    n_new = decay[..., None] * n_state + jnp.einsum('bhs,bhsd->bhd', w, k)
    return (c_new, n_new, m_new), h


def _mlstm_scan(q, k, v, log_i, log_f):
    bsz, nh, s, d = q.shape
    nc = s // MLSTM_CHUNK

    def chunks(t):
        t = t.reshape(bsz, nh, nc, MLSTM_CHUNK, *t.shape[3:])
        return jnp.moveaxis(t, 2, 0)

    init = (jnp.zeros((bsz, nh, d, d), F32), jnp.zeros((bsz, nh, d), F32), jnp.zeros((bsz, nh), F32))
    _, h = lax.scan(_mlstm_chunk_step, init, (chunks(q), chunks(k), chunks(v), chunks(log_i), chunks(log_f)))
    return jnp.moveaxis(h, 0, 2).reshape(bsz, nh, s, d)


def _mlstm_branch(q, k, v, o, gates, gate_bias, norm_gain):
    bsz, s, _ = q.shape

    def heads(t):
        return t.astype(F32).reshape(bsz, s, MLSTM_HEADS, MLSTM_HEAD_DIM).transpose(0, 2, 1, 3)

    qh, kh, vh = heads(q), heads(k) * (MLSTM_HEAD_DIM ** -0.5), heads(v)
    g = gates.astype(F32).reshape(bsz, s, 2, 2, MLSTM_HEADS) + gate_bias.astype(F32)
    g = jnp.moveaxis(g, 1, -1)
    log_i = g[:, :, 0]
    log_f = jax.nn.log_sigmoid(g[:, :, 1])
    h_fwd = _mlstm_scan(qh, kh, vh, log_i[:, 0], log_f[:, 0])

    def flip(t):
        return jnp.flip(t, axis=2)

    h_bwd = flip(_mlstm_scan(flip(qh), flip(kh), flip(vh), flip(log_i[:, 1]), flip(log_f[:, 1])))
    h = (h_fwd + h_bwd).transpose(0, 2, 1, 3)
    h = jax.nn.sigmoid(o.astype(F32)).reshape(bsz, s, MLSTM_HEADS, MLSTM_HEAD_DIM) * h
    mu = h.mean(-1, keepdims=True)
    var = jnp.square(h - mu).mean(-1, keepdims=True)
    h = ((h - mu) * lax.rsqrt(var + LN_EPS)).reshape(bsz, s, BRANCH_WIDTH) * norm_gain.astype(F32)
    return h.astype(q.dtype)


def _centred_short_conv(x, w, b):
    s = x.shape[1]
    xp = jnp.pad(x, ((0, 0), (1, 1), (0, 0)))
    return xp[:, :s] * w[0] + xp[:, 1:s + 1] * w[1] + xp[:, 2:] * w[2] + b


def _hyena_filters(seq_len, w1, b1, w2, b2, freq, w3, decay):
    pos = jnp.arange(seq_len, dtype=F32)
    t = pos / (seq_len - 1)
    bands = jnp.linspace(1e-4, HYENA_BANDS - 1, HYENA_BANDS, dtype=F32)
    ang = 2.0 * math.pi * pos[:, None] * bands[None, :] / seq_len
    feat = jnp.concatenate([t[:, None], jnp.cos(ang), -jnp.sin(ang)], axis=-1)
    freq = freq.astype(F32)
    h = jnp.sin(freq[0] * (feat @ w1.astype(F32) + b1.astype(F32)))
    h = jnp.sin(freq[1] * (h @ w2.astype(F32) + b2.astype(F32)))
    filt = (h @ w3.astype(F32)).reshape(seq_len, 2, HYENA_WIDTH)
    filt = filt * jnp.exp(-t[:, None, None] * jnp.abs(decay.astype(F32))[None])
    return filt / (jnp.sum(jnp.abs(filt), axis=0, keepdims=True) + 1e-6)


def _hyena_branch(p, conv_w, conv_b, w1, b1, w2, b2, freq, w3, decay, skip):
    seq_len = p.shape[1]
    u = _centred_short_conv(p, conv_w, conv_b)
    x0, x1, v = jnp.split(u, 3, axis=-1)
    z = (x1 * v).astype(F32)
    filt = _hyena_filters(seq_len, w1, b1, w2, b2, freq, w3, decay)
    two_sided = jnp.concatenate([filt[:, 0], jnp.zeros_like(filt[:1, 0]), jnp.flip(filt[1:, 1], axis=0)], axis=0)
    z_f = jnp.fft.rfft(z, n=2 * seq_len, axis=1)
    h_f = jnp.fft.rfft(two_sided, axis=0)
    y = jnp.fft.irfft(z_f * h_f[None], n=2 * seq_len, axis=1)[:, :seq_len]
    y = y + skip.astype(F32) * z
    return x0 * y.astype(x0.dtype)


def _ssm_combine(e1, e2):
    a1, b1 = e1
    a2, b2 = e2
    return a2 * a1, a2 * b1 + b2


def _s5_branch(u, lam_re, lam_im, log_step, b_re, b_im, c_re, c_im, skip):
    bsz, s, _ = u.shape
    ug = u.astype(F32).reshape(bsz, s, S5_GROUPS, S5_GROUP)
    lam = lax.complex(lam_re.astype(F32), lam_im.astype(F32))
    step = jnp.exp(log_step.astype(F32))[..., None]
    a_bar = jnp.exp(lam * step)
    b_mat = lax.complex(b_re.astype(F32), b_im.astype(F32))
    b_bar = ((a_bar - 1.0) / lam)[..., None] * b_mat
    c_mat = lax.complex(c_re.astype(F32), c_im.astype(F32))

    def run(d, reverse):
        bu = jnp.einsum('gpn,bsgn->bsgp', b_bar[d], ug)
        a = jnp.broadcast_to(a_bar[d], bu.shape)
        _, states = lax.associative_scan(_ssm_combine, (a, bu), reverse=reverse, axis=1)
        return jnp.einsum('gnp,bsgp->bsgn', c_mat[d], states).real

    y = run(0, False) + run(1, True) + skip.astype(F32).reshape(S5_GROUPS, S5_GROUP) * ug
    return y.reshape(bsz, s, S5_WIDTH).astype(u.dtype)


def _mixer(x, w_in, mlstm_gate_bias, mlstm_norm_gain, w_mlstm_out,
           hyena_conv_w, hyena_conv_b, hyena_w1, hyena_b1, hyena_w2, hyena_b2, hyena_freq, hyena_w3,
           hyena_decay, hyena_skip, w_hyena_out,
           s5_lambda_re, s5_lambda_im, s5_log_step, s5_b_re, s5_b_im, s5_c_re, s5_c_im, s5_skip, w_s5_glu,
           w_out):
    bsz, s, d = x.shape
    q, k, v, o, mg, hp, su, gate_pre = _split_in(x @ w_in)
    out_a = _mlstm_branch(q, k, v, o, mg, mlstm_gate_bias, mlstm_norm_gain) @ w_mlstm_out
    out_b = _hyena_branch(hp, hyena_conv_w, hyena_conv_b, hyena_w1, hyena_b1, hyena_w2, hyena_b2,
                          hyena_freq, hyena_w3, hyena_decay, hyena_skip) @ w_hyena_out
    s5y = _s5_branch(su, s5_lambda_re, s5_lambda_im, s5_log_step, s5_b_re, s5_b_im, s5_c_re, s5_c_im, s5_skip)
    glu_a, glu_g = jnp.split(s5y @ w_s5_glu, 2, axis=-1)
    out_c = glu_a * jax.nn.sigmoid(glu_g)
    g = jax.nn.sigmoid(gate_pre).reshape(bsz, s, N_BRANCHES, d)
    merged = g[:, :, 0] * out_a + g[:, :, 1] * out_b + g[:, :, 2] * out_c
    return merged @ w_out


def _peer(x, w_q, subkeys, u_tab, v_tab):
    bsz, s, d = x.shape
    t = x.reshape(bsz * s, d)
    n_tok = t.shape[0]
    q = (t @ w_q).astype(F32).reshape(n_tok, PEER_HEADS, 2, PEER_HALF)
    scores = jnp.einsum('thcd,hckd->thck', q, subkeys.astype(F32))
    top_v, top_i = lax.top_k(scores, PEER_TOPK)
    cand = top_v[:, :, 0, :, None] + top_v[:, :, 1, None, :]
    best_v, best_c = lax.top_k(cand.reshape(n_tok, PEER_HEADS, PEER_TOPK * PEER_TOPK), PEER_TOPK)
    i1 = jnp.take_along_axis(top_i[:, :, 0], best_c // PEER_TOPK, axis=-1)
    i2 = jnp.take_along_axis(top_i[:, :, 1], best_c % PEER_TOPK, axis=-1)
    expert = (i1 * PEER_KEYS + i2).reshape(n_tok, PEER_HEADS * PEER_TOPK)
    gate = jax.nn.softmax(best_v, axis=-1).reshape(n_tok, PEER_HEADS * PEER_TOPK)

    def block(args):
        xb, eb, gb = args
        act = jax.nn.gelu(jnp.einsum('td,ted->te', xb, u_tab[eb]).astype(F32))
        return jnp.einsum('te,ted->td', (act * gb).astype(xb.dtype), v_tab[eb])

    nb = n_tok // PEER_BLOCK
    out = lax.map(block, (t.reshape(nb, PEER_BLOCK, d),
                          expert.reshape(nb, PEER_BLOCK, -1),
                          gate.reshape(nb, PEER_BLOCK, -1)))
    return out.reshape(bsz, s, d)


def setup_inputs(seed: int = 0) -> dict:
    key = jax.random.key(seed)
    ks = iter(jax.random.split(key, 48))

    def nrm(shape, scale):
        return jax.random.normal(next(ks), shape, F32) * scale

    L = DEPTH
    ig = nrm((L, 2, MLSTM_HEADS), 0.1)
    fg = jnp.linspace(3.0, 6.0, MLSTM_HEADS, dtype=F32) + nrm((L, 2, MLSTM_HEADS), 0.1)
    min_decay = math.log(1e-2) / 1.5
    max_decay = math.log(1e-2) / 0.3
    deltas = jnp.linspace(min_decay, max_decay, HYENA_WIDTH, dtype=F32)
    n_idx = jnp.arange(S5_STATE, dtype=F32)
    return {
        'x': nrm((BATCH, SEQ, D_MODEL), 1.0),
        'w_in': nrm((L, D_MODEL, IN_COLS), D_MODEL ** -0.5),
        'mlstm_gate_bias': jnp.stack([ig, fg], axis=2),
        'mlstm_norm_gain': 1.0 + nrm((L, BRANCH_WIDTH), 0.02),
        'w_mlstm_out': nrm((L, BRANCH_WIDTH, D_MODEL), BRANCH_WIDTH ** -0.5),
        'hyena_conv_w': nrm((L, 3, 3 * HYENA_WIDTH), 3 ** -0.5),
        'hyena_conv_b': nrm((L, 3 * HYENA_WIDTH), 0.02),
        'hyena_w1': nrm((L, HYENA_EMB, HYENA_FILTER_HIDDEN), HYENA_EMB ** -0.5),
        'hyena_b1': nrm((L, HYENA_FILTER_HIDDEN), 0.02),
        'hyena_w2': nrm((L, HYENA_FILTER_HIDDEN, HYENA_FILTER_HIDDEN), HYENA_FILTER_HIDDEN ** -0.5),
        'hyena_b2': nrm((L, HYENA_FILTER_HIDDEN), 0.02),
        'hyena_freq': 1.0 + nrm((L, 2, HYENA_FILTER_HIDDEN), 0.02),
        'hyena_w3': nrm((L, HYENA_FILTER_HIDDEN, 2 * HYENA_WIDTH), HYENA_FILTER_HIDDEN ** -0.5),
        'hyena_decay': deltas[None, None] * (1.0 + nrm((L, 2, HYENA_WIDTH), 0.02)),
        'hyena_skip': nrm((L, HYENA_WIDTH), 1.0),
        'w_hyena_out': nrm((L, HYENA_WIDTH, D_MODEL), HYENA_WIDTH ** -0.5),
        's5_lambda_re': -0.5 + nrm((L, 2, S5_GROUPS, S5_STATE), 0.01),
        's5_lambda_im': math.pi * n_idx + nrm((L, 2, S5_GROUPS, S5_STATE), 0.01),
        's5_log_step': jax.random.uniform(next(ks), (L, 2, S5_GROUPS), F32, math.log(1e-3), math.log(1e-1)),
        's5_b_re': nrm((L, 2, S5_GROUPS, S5_STATE, S5_GROUP), (2 * S5_GROUP) ** -0.5),
        's5_b_im': nrm((L, 2, S5_GROUPS, S5_STATE, S5_GROUP), (2 * S5_GROUP) ** -0.5),
        's5_c_re': nrm((L, 2, S5_GROUPS, S5_GROUP, S5_STATE), (2 * S5_STATE) ** -0.5),
        's5_c_im': nrm((L, 2, S5_GROUPS, S5_GROUP, S5_STATE), (2 * S5_STATE) ** -0.5),
        's5_skip': nrm((L, S5_WIDTH), 1.0),
        'w_s5_glu': nrm((L, S5_WIDTH, 2 * D_MODEL), S5_WIDTH ** -0.5),
        'w_out': nrm((L, D_MODEL, D_MODEL), D_MODEL ** -0.5 * BETA),
        'ln1_g': 1.0 + nrm((L, D_MODEL), 0.02),
        'ln1_b': nrm((L, D_MODEL), 0.02),
        'peer_w_q': nrm((L, D_MODEL, PEER_HEADS * PEER_QDIM), D_MODEL ** -0.5),
        'peer_subkeys': nrm((L, PEER_HEADS, 2, PEER_KEYS, PEER_HALF), PEER_HALF ** -0.5),
        'peer_u': nrm((L, N_EXPERTS, D_MODEL), D_MODEL ** -0.5),
        'peer_v': nrm((L, N_EXPERTS, D_MODEL), (PEER_HEADS * PEER_TOPK) ** -0.5 * BETA),
        'ln2_g': 1.0 + nrm((L, D_MODEL), 0.02),
        'ln2_b': nrm((L, D_MODEL), 0.02),
    }


def reference(x, w_in, mlstm_gate_bias, mlstm_norm_gain, w_mlstm_out,
              hyena_conv_w, hyena_conv_b, hyena_w1, hyena_b1, hyena_w2, hyena_b2, hyena_freq, hyena_w3,
              hyena_decay, hyena_skip, w_hyena_out,
              s5_lambda_re, s5_lambda_im, s5_log_step, s5_b_re, s5_b_im, s5_c_re, s5_c_im, s5_skip, w_s5_glu,
              w_out, ln1_g, ln1_b, peer_w_q, peer_subkeys, peer_u, peer_v, ln2_g, ln2_b):
    for l in range(DEPTH):
        mix = _mixer(x, w_in[l], mlstm_gate_bias[l], mlstm_norm_gain[l], w_mlstm_out[l],
                     hyena_conv_w[l], hyena_conv_b[l], hyena_w1[l], hyena_b1[l], hyena_w2[l], hyena_b2[l],
                     hyena_freq[l], hyena_w3[l], hyena_decay[l], hyena_skip[l], w_hyena_out[l],
                     s5_lambda_re[l], s5_lambda_im[l], s5_log_step[l], s5_b_re[l], s5_b_im[l],
                     s5_c_re[l], s5_c_im[l], s5_skip[l], w_s5_glu[l], w_out[l])
        x = _layer_norm(ALPHA * x + mix, ln1_g[l], ln1_b[l])
        ffn = _peer(x, peer_w_q[l], peer_subkeys[l], peer_u[l], peer_v[l])
        x = _layer_norm(ALPHA * x + ffn, ln2_g[l], ln2_b[l])
    return x
```

```cpp
#include <hip/hip_runtime.h>
#include <stdint.h>
#include <stdio.h>

#define DI __device__ __forceinline__
#define LAS __attribute__((address_space(3)))
typedef unsigned short bf16_t;
typedef short bf16x8 __attribute__((ext_vector_type(8)));
typedef float f32x4 __attribute__((ext_vector_type(4)));
typedef float f32x2 __attribute__((ext_vector_type(2)));
typedef f32x2 cf2;
__device__ __forceinline__ cf2 mk2(float a, float b) { cf2 r; r.x = a; r.y = b; return r; }
typedef unsigned u32x4 __attribute__((ext_vector_type(4)));
typedef unsigned u32x2 __attribute__((ext_vector_type(2)));

constexpr int T = 8192, DM = 2048, BW = 1024, NL = 4, NIN = 14352;
constexpr float ALPHA = 1.6817928305074290f;
constexpr float LN_EPS = 1e-5f;
constexpr int NTHREADS = 512;
constexpr int LDS_BYTES = 153600;

constexpr size_t al256(size_t x) { return (x + 255) & ~(size_t)255; }
constexpr size_t O_BAR  = 0;
constexpr size_t O_TW   = 16384;
constexpr size_t O_WIN1 = O_TW + 131072;
constexpr size_t O_WIN2 = O_WIN1 + (size_t)NL * 10240 * 2048 * 2;
constexpr size_t O_WGT  = O_WIN2 + (size_t)NL * 4096 * 2048 * 2;
constexpr size_t O_WA   = O_WGT + (size_t)NL * 16 * 2048 * 4;
constexpr size_t O_WB   = O_WA + (size_t)NL * 2048 * 1024 * 2;
constexpr size_t O_WC   = O_WB + (size_t)NL * 2048 * 1024 * 2;
constexpr size_t O_WO   = O_WC + (size_t)NL * 4096 * 1024 * 2;
constexpr size_t O_WS   = O_WO + (size_t)NL * 2048 * 2048 * 2;
constexpr size_t O_U16  = O_WS + (size_t)NL * 2048 * 2048 * 2;
constexpr size_t O_V16  = O_U16 + (size_t)16384 * 2048 * 2;
constexpr size_t O_HID2 = O_V16 + (size_t)16384 * 2048 * 2;
constexpr int PM_STRIDE = 8200;
constexpr size_t O_PM   = O_HID2 + (size_t)NL * 8192 * 64 * 4;
constexpr size_t O_XB   = O_PM + (size_t)NL * 512 * PM_STRIDE * 16;
constexpr size_t O_XF   = O_XB + (size_t)T * DM * 2;
constexpr size_t O_Q    = O_XF + (size_t)T * DM * 4;
constexpr size_t O_FT   = O_Q;
constexpr size_t O_K    = O_Q + (size_t)T * 1024 * 2;
constexpr size_t O_O    = O_K + (size_t)T * 1024 * 2;
constexpr size_t O_SU   = O_O + (size_t)T * 1024 * 2;
constexpr size_t O_G    = O_SU + (size_t)T * 1024 * 4;
constexpr size_t O_KT   = O_G + (size_t)T * 6144 * 2;
constexpr size_t O_VT   = O_KT + (size_t)1024 * T * 2;
constexpr size_t O_HPT  = O_VT + (size_t)1024 * T * 2;
constexpr size_t O_SCT  = O_HPT;
constexpr int SCT_LD = T + 64;
constexpr size_t O_MG   = O_HPT + (size_t)3072 * T * 4;
constexpr size_t O_KV   = O_MG + (size_t)T * 16 * 4;
constexpr size_t O_MRG  = O_KV;
constexpr size_t O_YSD  = O_KV;
constexpr size_t O_Y1   = O_KV + (size_t)T * DM * 4;
constexpr size_t O_NLOC = O_KV + (size_t)512 * 65536 * 4;
constexpr size_t O_MLOC = O_NLOC + (size_t)512 * 256 * 4;
constexpr size_t O_BLAST= O_MLOC + 4096;
constexpr size_t O_CST  = O_BLAST + 4096;
constexpr size_t O_NST  = O_CST + (size_t)512 * 65536 * 2;
constexpr size_t O_MST  = O_NST + (size_t)512 * 256 * 4;
constexpr size_t O_HDIR = O_MST + 4096;
constexpr size_t O_HN   = O_HDIR + (size_t)2 * T * 1024 * 4;
constexpr size_t O_YH   = O_HN + (size_t)T * 1024 * 2;
constexpr size_t O_YS   = O_YH + (size_t)T * 1024 * 2;
constexpr size_t O_S5W  = O_YS + (size_t)T * 1024 * 2;
constexpr size_t O_S5E  = O_S5W + (size_t)NL * 64 * 256 * 512 * 2;
constexpr size_t O_XE   = O_S5E + (size_t)NL * 64 * 256 * 256 * 2;
constexpr size_t O_XIN  = O_XE + (size_t)64 * 512 * 256 * 4;
constexpr size_t O_MRGB = O_XIN + (size_t)64 * 512 * 256 * 2;
constexpr size_t O_X1F  = O_MRGB + (size_t)T * DM * 2;
constexpr size_t O_X1B  = O_X1F + (size_t)T * DM * 4;
constexpr size_t WS_NEED = O_X1B + (size_t)T * DM * 2;
constexpr size_t O_Y1B  = O_X1B;
constexpr size_t O_STAT = O_X1F;
constexpr size_t O_C1P  = O_X1F + ((size_t)4 << 20);
constexpr size_t O_C2P  = O_X1F + ((size_t)8 << 20);
constexpr size_t O_C1   = O_X1F + ((size_t)12 << 20);
constexpr size_t O_C2   = O_C1 + 65536;
constexpr size_t O_WGB  = O_X1F + ((size_t)13 << 20);
static_assert(WS_NEED < ((size_t)1 << 31), "workspace too large");
static_assert(O_MG - O_Q >= (size_t)NL * 2048 * 8192 * 4, "filter-tap alias does not fit");

#ifndef R_PROA
#define R_PROA 1
#endif
#ifndef R_PROB
#define R_PROB 1
#endif
#ifndef R_INP
#define R_INP 1
#endif
#ifndef R_LOC
#define R_LOC 1
#endif
#ifndef R_LA
#define R_LA 1
#endif
#ifndef R_LH
#define R_LH 1
#endif
#ifndef R_LS
#define R_LS 1
#endif
#ifndef R_OM
#define R_OM 1
#endif
#ifndef R_OS
#define R_OS 1
#endif
#ifndef R_SCAN
#define R_SCAN 1
#endif
#ifndef R_OUT
#define R_OUT 1
#endif
#ifndef R_FIN
#define R_FIN 1
#endif
#ifndef R_BR
#define R_BR 1
#endif
#ifndef R_WOUT
#define R_WOUT 1
#endif
#ifndef R_LN1
#define R_LN1 1
#endif
#ifndef R_SC
#define R_SC 1
#endif
#ifndef R_PEER
#define R_PEER 1
#endif
struct Params { const float* in[34]; float* out; unsigned char* ws; };
typedef const __attribute__((address_space(4))) Params* KParams;
#define PHASE_ARGS(q, tid) Params q; { KParams kp_ = (KParams)__builtin_amdgcn_kernarg_segment_ptr(); asm volatile("" : "+s"(kp_)); \
    _Pragma("unroll") for (int i_ = 0; i_ < 34; ++i_) q.in[i_] = kp_->in[i_]; q.out = kp_->out; q.ws = kp_->ws; } \
    int wid = wid_s_; asm volatile("" : "+s"(wid)); int lane; asm volatile("v_mbcnt_lo_u32_b32 %0, -1, 0\n\tv_mbcnt_hi_u32_b32 %0, -1, %0" : "=v"(lane)); const int tid = wid * 64 + lane; (void)wid; (void)lane; \
    const int bid = blockIdx.x, G = gridDim.x; const int gtid = bid * NTHREADS + tid, gthreads = G * NTHREADS, gwave = bid * 8 + wid, gwaves = G * 8; \
    (void)gtid; (void)gthreads; (void)gwave; (void)gwaves; unsigned char* ws = q.ws; (void)ws;
enum { I_X = 0, I_WIN, I_MGB, I_MNG, I_WMO, I_HCW, I_HCB, I_HW1, I_HB1, I_HW2, I_HB2, I_HFQ, I_HW3, I_HDC, I_HSK, I_WHO,
       I_SLR, I_SLI, I_SLS, I_SBR, I_SBI, I_SCR, I_SCI, I_SSK, I_WSG, I_WOUT, I_L1G, I_L1B, I_PWQ, I_PSK, I_PU, I_PV, I_L2G, I_L2B };

typedef __bf16 bf16x2v __attribute__((ext_vector_type(2)));
DI unsigned pk_bf16(float lo, float hi) { f32x2 v; v.x = lo; v.y = hi; return __builtin_bit_cast(unsigned, __builtin_convertvector(v, bf16x2v)); }
DI float bf_lo(unsigned w) { return __uint_as_float(w << 16); }
DI float bf_hi(unsigned w) { return __uint_as_float(w & 0xffff0000u); }
DI float sigmoidf_(float x) { return __builtin_amdgcn_rcpf(1.0f + __expf(-x)); }
DI float wave_sum(float v) { for (int o = 32; o > 0; o >>= 1) v += __shfl_xor(v, o); return v; }
DI float wave_max(float v) { for (int o = 32; o > 0; o >>= 1) v = fmaxf(v, __shfl_xor(v, o)); return v; }
DI float wave_scan_add(float v, int lane) { for (int o = 1; o < 64; o <<= 1) { float t = __shfl_up(v, o); if (lane >= o) v += t; } return v; }
DI float wave_scan_max(float v, int lane) { for (int o = 1; o < 64; o <<= 1) { float t = __shfl_up(v, o); if (lane >= o) v = fmaxf(v, t); } return v; }
DI cf2 cmul(cf2 a, cf2 b) { return mk2(a.x * b.x - a.y * b.y, a.x * b.y + a.y * b.x); }
DI cf2 cmulc(cf2 a, cf2 b) { return mk2(a.x * b.x + a.y * b.y, a.y * b.x - a.x * b.y); }

#define XB_TMO      128
#define XB_XCNT(j)  (256  + 64 * (j))
#define XB_XSUB(j)  (1280 + 64 * (j))
#define XB_XGEN(j)  (2304 + 64 * (j))
#define XB_TOP      3328
#define XB_TOPGEN   3392
#define XCD_BAR_WORDS 3456
#define XB_SPIN_CAP (1u << 22)
DI unsigned xb_ld(unsigned* p)              { return __hip_atomic_load(p, __ATOMIC_RELAXED, __HIP_MEMORY_SCOPE_AGENT); }
DI unsigned xb_add(unsigned* p, unsigned v) { return __hip_atomic_fetch_add(p, v, __ATOMIC_RELAXED, __HIP_MEMORY_SCOPE_AGENT); }
DI unsigned xb_xcc_id() { return (unsigned)__builtin_amdgcn_s_getreg((3 << 11) | 20) & 0xFu; }
#define XB_SPIN(cond, bar) do { unsigned _sp = 0; while (cond) { __builtin_amdgcn_s_sleep(1); \
    if ((++_sp & 255u) == 0u) { if (xb_ld(&(bar)[XB_TMO])) break; if (_sp > XB_SPIN_CAP) { atomicAdd(&(bar)[XB_TMO], 1u); break; } } } } while (0)
DI void xcd_barrier_complete(unsigned* bar, unsigned x, unsigned& nloc, unsigned& nx) {
    const unsigned G = gridDim.x * gridDim.y * gridDim.z;
    unsigned sum, cnt, mine, sp = 0u;
    for (;;) {
        sum = 0u; cnt = 0u; mine = 0u;
#pragma unroll
        for (unsigned j = 0; j < 16; ++j) { const unsigned c = xb_ld(&bar[XB_XCNT(j)]); sum += c; cnt += (c > 0u) ? 1u : 0u; mine = (j == x) ? c : mine; }
        if (sum == G) break;
        __builtin_amdgcn_s_sleep(1);
        if ((++sp & 255u) == 0u) { if (xb_ld(&bar[XB_TMO])) break; if (sp > XB_SPIN_CAP) { atomicAdd(&bar[XB_TMO], 1u); break; } }
    }
    nloc = mine > 0u ? mine : 1u; nx = cnt > 0u ? cnt : 1u;
}
DI void xcd_barrier_post(unsigned* bar) { if (threadIdx.x == 0) (void)xb_add(&bar[XB_XCNT(xb_xcc_id())], 1u); }
DI void xcd_barrier(unsigned* bar_in, volatile LAS unsigned* st, const bool is_t0) {
    asm volatile("s_waitcnt vmcnt(0)" ::: "memory");
    __syncthreads();
    if (is_t0) {
        unsigned* bar = bar_in; asm volatile("" : "+s"(bar));
        const unsigned x = xb_xcc_id();
        __builtin_amdgcn_s_waitcnt(0);
        unsigned nloc = st[0], nx = st[1];
        if (nloc == 0u) { xcd_barrier_complete(bar, x, nloc, nx); st[0] = nloc; st[1] = nx; }
        const unsigned old = xb_add(&bar[XB_XSUB(x)], 1u);
        const unsigned gen = old / nloc;
        if (old + 1u == (gen + 1u) * nloc) {
            __builtin_amdgcn_fence(__ATOMIC_RELEASE, "agent");
            asm volatile("s_waitcnt vmcnt(0)" ::: "memory");
            const unsigned og = xb_add(&bar[XB_TOP], 1u);
            const unsigned tg = og / nx;
            if (og + 1u == (tg + 1u) * nx) xb_add(&bar[XB_TOPGEN], 1u);
            else XB_SPIN(xb_ld(&bar[XB_TOPGEN]) == tg, bar);
            __builtin_amdgcn_fence(__ATOMIC_ACQUIRE, "agent");
            xb_add(&bar[XB_XGEN(x)], 1u);
            asm volatile("s_waitcnt vmcnt(0)" ::: "memory");
        } else {
            XB_SPIN(xb_ld(&bar[XB_XGEN(x)]) == gen, bar);
            __builtin_amdgcn_fence(__ATOMIC_ACQUIRE, "agent");
            asm volatile("s_waitcnt vmcnt(0)" ::: "memory");
        }
    }
    __syncthreads();
}
#define GRID_BARRIER() do { KParams kb_ = (KParams)__builtin_amdgcn_kernarg_segment_ptr(); asm volatile("" : "+s"(kb_)); \
    xcd_barrier((unsigned*)(kb_->ws + O_BAR), (volatile LAS unsigned*)(lds + LDS_BYTES - 16), wid_s_ == 0 && __builtin_amdgcn_mbcnt_hi(~0u, __builtin_amdgcn_mbcnt_lo(~0u, 0u)) == 0u); } while (0)

namespace pg8 {
constexpr int BM = 256, BK = 64, HALF = 128, HTB = HALF * BK * 2, STAGE_BYTES = 8 * HTB, NXCD = 8, WGM = 8;
DI int lds_byte(int r, int c) { const int st = (r >> 4) * 2 + (c >> 5), rr = r & 15, cc = c & 31, ob = rr * 64 + cc * 2; return st * 1024 + (ob ^ (((ob >> 9) & 1) << 5)); }
DI void stage_rc(int b, int& R, int& C) { const int st = b / 1024, sb = b % 1024, swz = sb ^ (((sb >> 9) & 1) << 5); R = (st >> 1) * 16 + swz / 64; C = (st & 1) * 32 + (swz % 64) / 2; }
DI int perm32(int rho) { const int n = rho >> 4, i = rho & 15; return 8 * (i >> 2) + 4 * n + (i & 3); }
struct Unit { int pm, pn, which; };
struct Gemm { const bf16_t* A; const bf16_t* Bt; int M, N, K; };
struct StaticOrder {
    int nM, nN, nwg, G, c;
    DI void init(int M, int N, int G_, int c_) { nM = M / BM; nN = N / BM; nwg = nM * nN; G = G_; c = c_; }
    DI bool next(int i, Unit& u) const {
        const long L = (long)i * G + c; if (L >= nwg) return false;
        int wgid = (int)L; { const int q = nwg / NXCD, r = nwg % NXCD, xcd = wgid % NXCD, off = wgid / NXCD; wgid = (xcd < r ? xcd * (q + 1) : r * (q + 1) + (xcd - r) * q) + off; }
        const int nig = WGM * nN, gid = wgid / nig, fm = gid * WGM, gsz = (nM - fm) < WGM ? (nM - fm) : WGM;
        u.pm = fm + ((wgid % nig) % gsz); u.pn = (wgid % nig) / gsz; u.which = 0; return true;
    }
    DI void a_ready(const Unit&) const {}
    DI void done(const Unit&) const {}
    DI const char* a_base(const Gemm& g, const Unit& u, size_t tstep) const { return (const char*)g.A + (size_t)u.pm * tstep; }
    DI const char* b_base(const Gemm& g, const Unit& u, size_t tstep) const { return (const char*)g.Bt + (size_t)u.pn * tstep; }
};
struct BranchOrder {
    StaticOrder base; const bf16_t *A0, *A1, *A2, *B0, *B1, *B2;
    DI bool next(int i, Unit& u) const { Unit b; if (i > 3 || !base.next(0, b)) return false; u.pm = b.pm; u.which = i; u.pn = i < 2 ? b.pn : 2 * b.pn + (i - 2); return true; }
    DI void a_ready(const Unit&) const {}
    DI void done(const Unit&) const {}
    DI const char* a_base(const Gemm&, const Unit& u, size_t tstep) const { const bf16_t *a0 = A0, *a1 = A1, *a2 = A2; asm volatile("" : "+s"(a0), "+s"(a1), "+s"(a2));
        return (const char*)(u.which == 0 ? a0 : (u.which == 1 ? a1 : a2)) + (size_t)u.pm * tstep; }
    DI const char* b_base(const Gemm&, const Unit& u, size_t tstep) const { const bf16_t *b0 = B0, *b1 = B1, *b2 = B2; asm volatile("" : "+s"(b0), "+s"(b1), "+s"(b2));
        return (const char*)(u.which == 0 ? b0 : (u.which == 1 ? b1 : b2)) + (size_t)u.pn * tstep; }
};

template <class Epi, class Sched>
DI void gemm_phase(LAS unsigned char* lds, const Gemm g, const Sched& S, const Epi& E, const int tid) {
    const int wid = __builtin_amdgcn_readfirstlane(tid >> 6), lane = tid & 63, wr = wid >> 2, wc = wid & 3, fr = lane & 15, fq = lane >> 4;
    const int K = g.K, nt = K / BK;
    unsigned voffA[2], voffB[2];
#pragma unroll
    for (int i = 0; i < 2; ++i) { int R, C; stage_rc(tid * 16 + i * 8192, R, C); const int Rb = Epi::PERM ? ((R & ~31) + perm32(R & 31)) : R;
        voffA[i] = (unsigned)(R * K + C) * 2u; voffB[i] = (unsigned)(Rb * K + C) * 2u; }
    const size_t kstep = (size_t)(BK * 2);
    const size_t hstep = (size_t)HALF * K * 2;
    const size_t tstep = 2 * hstep;
    const unsigned ldsw = (unsigned)wid * 1024u;
    const int aoff = lds_byte(wr * 64 + fr, fq * 8), boff = lds_byte(wc * 32 + fr, fq * 8);
#define PG8_SA(b, h) (((b) * 2 + (h)) * HTB)
#define PG8_SB(b, h) ((4 + (b) * 2 + (h)) * HTB)
#define PG8_STAGE(bufoff, gbase, voff) do { _Pragma("unroll") for (int _i = 0; _i < 2; ++_i) \
        __builtin_amdgcn_global_load_lds((const unsigned*)((const char*)(gbase) + (voff)[_i]), (LAS unsigned*)(lds + (bufoff) + ldsw + _i * 8192), 16, 0, 0); } while (0)
#define PG8_LDA(dst, b, h) do { _Pragma("unroll") for (int m = 0; m < 4; ++m) _Pragma("unroll") for (int k = 0; k < 2; ++k) dst[m][k] = *(const LAS bf16x8*)(lds + PG8_SA(b, h) + aoff + m * 2048 + k * 1024); } while (0)
#define PG8_LDB(dst, b, h) do { _Pragma("unroll") for (int n = 0; n < 2; ++n) _Pragma("unroll") for (int k = 0; k < 2; ++k) dst[n][k] = *(const LAS bf16x8*)(lds + PG8_SB(b, h) + boff + n * 2048 + k * 1024); } while (0)
#define PG8_MMA(ai, bj, At, Bt) do { __builtin_amdgcn_s_setprio(1); _Pragma("unroll") for (int m = 0; m < 4; ++m) _Pragma("unroll") for (int n = 0; n < 2; ++n) _Pragma("unroll") for (int k = 0; k < 2; ++k) \
        acc[ai][bj][m][n] = __builtin_amdgcn_mfma_f32_16x16x32_bf16(Bt[n][k], At[m][k], acc[ai][bj][m][n], 0, 0, 0); __builtin_amdgcn_s_setprio(0); } while (0)
#define PG8_WAIT_V(n) asm volatile("s_waitcnt vmcnt(" #n ")" ::: "memory")
#define PG8_WAIT_L(n) asm volatile("s_waitcnt lgkmcnt(" #n ")" ::: "memory")
#define PG8_BAR __builtin_amdgcn_s_barrier()
#define PG8_SCHED __builtin_amdgcn_sched_barrier(0)
    Unit cur, nxt; int ui = 0;
    if (!S.next(0, cur)) return;
    f32x4 acc[2][2][4][2];
#pragma unroll
    for (int a = 0; a < 2; ++a)
#pragma unroll
        for (int b = 0; b < 2; ++b)
#pragma unroll
            for (int m = 0; m < 4; ++m)
#pragma unroll
                for (int n = 0; n < 2; ++n) acc[a][b][m][n] = (f32x4){0.f, 0.f, 0.f, 0.f};
    bf16x8 At[4][2], B0[2][2], B1[2][2];
    const char* cA = S.a_base(g, cur, tstep); const char* cB = S.b_base(g, cur, tstep);
    S.a_ready(cur);
    PG8_STAGE(PG8_SB(0, 0), cB, voffB); PG8_STAGE(PG8_SA(0, 0), cA, voffA); PG8_STAGE(PG8_SB(0, 1), cB + hstep, voffB); PG8_STAGE(PG8_SA(0, 1), cA + hstep, voffA);
    if (wr == 1) PG8_BAR;
    PG8_WAIT_V(4); PG8_BAR;
    PG8_STAGE(PG8_SB(1, 0), cB + kstep, voffB); PG8_STAGE(PG8_SA(1, 0), cA + kstep, voffA); PG8_STAGE(PG8_SB(1, 1), cB + hstep + kstep, voffB);
    PG8_WAIT_V(6); PG8_BAR;
    for (;;) {
        const bool has_next = S.next(ui + 1, nxt);
        const char* nA = has_next ? S.a_base(g, nxt, tstep) : cA; const char* nB = has_next ? S.b_base(g, nxt, tstep) : cB;
        for (int t = 0; t < nt; t += 2) {
            const bool last = (t == nt - 2);
            const char* a1 = cA + (size_t)(t + 1) * kstep;
            const char* a2 = last ? nA : cA + (size_t)(t + 2) * kstep; const char* b2 = last ? nB : cB + (size_t)(t + 2) * kstep;
            const char* a3 = a2 + kstep; const char* b3 = b2 + kstep;
            if (last && has_next) S.a_ready(nxt);
            PG8_LDB(B0, 0, 0); PG8_SCHED; PG8_LDA(At, 0, 0); PG8_STAGE(PG8_SA(1, 1), a1 + hstep, voffA);
            PG8_WAIT_L(8); PG8_BAR; PG8_WAIT_L(0); PG8_MMA(0, 0, At, B0); PG8_BAR; PG8_SCHED;
            PG8_LDB(B1, 0, 1); PG8_STAGE(PG8_SB(0, 0), b2, voffB);
            PG8_BAR; PG8_WAIT_L(0); PG8_MMA(0, 1, At, B1); PG8_BAR;
            PG8_LDA(At, 0, 1); PG8_STAGE(PG8_SA(0, 0), a2, voffA);
            PG8_BAR; PG8_WAIT_L(0); PG8_MMA(1, 0, At, B0); PG8_BAR; PG8_SCHED;
            PG8_STAGE(PG8_SB(0, 1), b2 + hstep, voffB);
            PG8_WAIT_V(6); PG8_BAR; PG8_MMA(1, 1, At, B1); PG8_BAR;
            PG8_LDB(B0, 1, 0); PG8_SCHED; PG8_LDA(At, 1, 0); PG8_STAGE(PG8_SA(0, 1), a2 + hstep, voffA);
            PG8_WAIT_L(8); PG8_BAR; PG8_WAIT_L(0); PG8_MMA(0, 0, At, B0); PG8_BAR; PG8_SCHED;
            PG8_LDB(B1, 1, 1); PG8_STAGE(PG8_SB(1, 0), b3, voffB);
            PG8_BAR; PG8_WAIT_L(0); PG8_MMA(0, 1, At, B1); PG8_BAR;
            PG8_LDA(At, 1, 1); PG8_STAGE(PG8_SA(1, 0), a3, voffA);
            PG8_BAR; PG8_WAIT_L(0); PG8_MMA(1, 0, At, B0); PG8_BAR; PG8_SCHED;
            PG8_STAGE(PG8_SB(1, 1), b3 + hstep, voffB);
            PG8_WAIT_V(6); PG8_BAR; PG8_MMA(1, 1, At, B1); PG8_BAR;
        }
        E(acc, cur, wr, wc, fr, fq);
        if (!has_next) break;
#pragma unroll
        for (int a = 0; a < 2; ++a)
#pragma unroll
            for (int b = 0; b < 2; ++b)
#pragma unroll
                for (int m = 0; m < 4; ++m)
#pragma unroll
                    for (int n = 0; n < 2; ++n) acc[a][b][m][n] = (f32x4){0.f, 0.f, 0.f, 0.f};
        cur = nxt; cA = nA; cB = nB; ++ui;
    }
    PG8_WAIT_V(0);
    if (wr == 0) PG8_BAR;
    PG8_BAR;
#undef PG8_SA
#undef PG8_SB
#undef PG8_STAGE
#undef PG8_LDA
#undef PG8_LDB
#undef PG8_MMA
#undef PG8_WAIT_V
#undef PG8_WAIT_L
#undef PG8_BAR
#undef PG8_SCHED
}

DI u32x4 pack8(const f32x4& a, const f32x4& b) { return (u32x4){pk_bf16(a[0], a[1]), pk_bf16(a[2], a[3]), pk_bf16(b[0], b[1]), pk_bf16(b[2], b[3])}; }
DI f32x4 sig4(const f32x4& a) { return (f32x4){sigmoidf_(a[0]), sigmoidf_(a[1]), sigmoidf_(a[2]), sigmoidf_(a[3])}; }

struct EpiIn1 {
    static constexpr bool PERM = true;
    bf16_t *Q, *K, *O, *G, *SUG;
    DI void operator()(const f32x4 (&acc)[2][2][4][2], const Unit& u, int wr, int wc, int fr, int fq) const {
        const int row0 = u.pm * BM + wr * 64 + fr, colt = u.pn * BM + wc * 32 + 8 * fq;
#pragma unroll
        for (int ai = 0; ai < 2; ++ai)
#pragma unroll
            for (int m = 0; m < 4; ++m) { const size_t row = (size_t)(row0 + ai * HALF + m * 16);
#pragma unroll
                for (int bj = 0; bj < 2; ++bj) { const int c = colt + bj * HALF; const f32x4 v0 = acc[ai][bj][m][0], v1 = acc[ai][bj][m][1];
                    if (u.pn < 4)       *(u32x4*)(Q + row * 1024 + c) = pack8(v0, v1);
                    else if (u.pn < 8)  *(u32x4*)(K + row * 1024 + (c - 1024)) = pack8(v0 * 0.0625f, v1 * 0.0625f);
                    else if (u.pn < 12) *(u32x4*)(O + row * 1024 + (c - 2048)) = pack8(v0, v1);
                    else if (u.pn < 16) { const int ch = c - 3072; *(u32x4*)(SUG + ((size_t)(ch >> 4) * T + row) * 16 + (ch & 15)) = pack8(v0, v1); }
                    else                *(u32x4*)(G + row * 6144 + (c - 4096)) = pack8(sig4(v0), sig4(v1));
                } }
    }
};
struct EpiIn2 {
    static constexpr bool PERM = true;
    bf16_t *VT, *HPT;
    DI void operator()(const f32x4 (&acc)[2][2][4][2], const Unit& u, int wr, int wc, int fr, int fq) const {
        const int row0 = u.pm * BM + wr * 64 + fr, colt = u.pn * BM + wc * 32 + 8 * fq;
#pragma unroll
        for (int ai = 0; ai < 2; ++ai)
#pragma unroll
            for (int m = 0; m < 4; ++m) { const int row = row0 + ai * HALF + m * 16;
#pragma unroll
                for (int bj = 0; bj < 2; ++bj) { const int c = colt + bj * HALF; const f32x4 v0 = acc[ai][bj][m][0], v1 = acc[ai][bj][m][1];
                    if (u.pm < 4) *(u32x4*)(VT + (size_t)row * T + c) = pack8(v0, v1);
                    else *(u32x4*)(HPT + (size_t)(row - 1024) * T + c) = pack8(v0, v1);
                } }
    }
};
struct EpiBranchAll {
    static constexpr bool PERM = true;
    const bf16_t* G; bf16_t *T1, *T2, *MRGB;
    DI void operator()(const f32x4 (&acc)[2][2][4][2], const Unit& u, int wr, int wc, int fr, int fq) const {
        const int row0 = u.pm * BM + wr * 64 + fr;
        if (u.which < 2) {
            const int colt = u.pn * BM + wc * 32 + 8 * fq; bf16_t* Td = u.which ? T2 : T1;
#pragma unroll
            for (int ai = 0; ai < 2; ++ai)
#pragma unroll
                for (int m = 0; m < 4; ++m) { const size_t row = (size_t)(row0 + ai * HALF + m * 16);
#pragma unroll
                    for (int bj = 0; bj < 2; ++bj) { const int c = colt + bj * HALF;
                        const u32x4 gw = *(const u32x4*)(G + row * 6144 + u.which * 2048 + c);
                        const f32x4 g0 = (f32x4){bf_lo(gw[0]), bf_hi(gw[0]), bf_lo(gw[1]), bf_hi(gw[1])}, g1 = (f32x4){bf_lo(gw[2]), bf_hi(gw[2]), bf_lo(gw[3]), bf_hi(gw[3])};
                        *(u32x4*)(Td + row * DM + c) = pack8(g0 * acc[ai][bj][m][0], g1 * acc[ai][bj][m][1]); } }
        } else {
            const int c = u.pn * HALF + wc * 32 + 8 * fq;
#pragma unroll
            for (int ai = 0; ai < 2; ++ai)
#pragma unroll
                for (int m = 0; m < 4; ++m) { const size_t row = (size_t)(row0 + ai * HALF + m * 16);
                    const u32x4 gw = *(const u32x4*)(G + row * 6144 + 2 * 2048 + c), t1 = *(const u32x4*)(T1 + row * DM + c), t2 = *(const u32x4*)(T2 + row * DM + c);
                    const f32x4 g0 = (f32x4){bf_lo(gw[0]), bf_hi(gw[0]), bf_lo(gw[1]), bf_hi(gw[1])}, g1 = (f32x4){bf_lo(gw[2]), bf_hi(gw[2]), bf_lo(gw[3]), bf_hi(gw[3])};
                    const f32x4 s0 = (f32x4){bf_lo(t1[0]) + bf_lo(t2[0]), bf_hi(t1[0]) + bf_hi(t2[0]), bf_lo(t1[1]) + bf_lo(t2[1]), bf_hi(t1[1]) + bf_hi(t2[1])};
                    const f32x4 s1 = (f32x4){bf_lo(t1[2]) + bf_lo(t2[2]), bf_hi(t1[2]) + bf_hi(t2[2]), bf_lo(t1[3]) + bf_lo(t2[3]), bf_hi(t1[3]) + bf_hi(t2[3])};
                    *(u32x4*)(MRGB + row * DM + c) = pack8(s0 + g0 * acc[ai][0][m][0] * sig4(acc[ai][1][m][0]), s1 + g1 * acc[ai][0][m][1] * sig4(acc[ai][1][m][1]));
                }
        }
    }
};
struct EpiWout {
    static constexpr bool PERM = true;
    const float* X; float* Y1; bf16_t* Y1B; float* STAT;
    DI void operator()(const f32x4 (&acc)[2][2][4][2], const Unit& u, int wr, int wc, int fr, int fq) const {
        const int row0 = u.pm * BM + wr * 64 + fr, colt = u.pn * BM + wc * 32 + 8 * fq;
#pragma unroll
        for (int ai = 0; ai < 2; ++ai)
#pragma unroll
            for (int m = 0; m < 4; ++m) { const size_t row = (size_t)(row0 + ai * HALF + m * 16);
                float s1 = 0.f, s2 = 0.f;
#pragma unroll
                for (int bj = 0; bj < 2; ++bj) { const size_t o = row * DM + colt + bj * HALF;
                    const f32x4 y0 = ALPHA * *(const f32x4*)(X + o) + acc[ai][bj][m][0], y1 = ALPHA * *(const f32x4*)(X + o + 4) + acc[ai][bj][m][1];
                    *(f32x4*)(Y1 + o) = y0; *(f32x4*)(Y1 + o + 4) = y1; *(u32x4*)(Y1B + o) = pack8(y0, y1);
#pragma unroll
                    for (int e = 0; e < 4; ++e) { s1 += y0[e] + y1[e]; s2 += y0[e] * y0[e] + y1[e] * y1[e]; } }
                s1 += __shfl_xor(s1, 16); s1 += __shfl_xor(s1, 32); s2 += __shfl_xor(s2, 16); s2 += __shfl_xor(s2, 32);
                if (fq == 0) *(f32x2*)(STAT + (row * 32 + u.pn * 4 + wc) * 2) = (f32x2){s1, s2};
            }
    }
};
struct EpiScore {
    static constexpr bool PERM = true;
    bf16_t* C; const float *C1, *C2; const LAS float* MS;
    DI void operator()(const f32x4 (&acc)[2][2][4][2], const Unit& u, int wr, int wc, int fr, int fq) const {
        const int row0 = u.pm * BM + wr * 64 + fr, tl0 = wc * 32 + 8 * fq, colt = u.pn * BM + tl0;
        f32x4 mu[2][2], rs[2][2];
#pragma unroll
        for (int bj = 0; bj < 2; ++bj)
#pragma unroll
            for (int n = 0; n < 2; ++n)
#pragma unroll
                for (int e = 0; e < 4; ++e) { const int tl = tl0 + bj * HALF + 4 * n + e; mu[bj][n][e] = MS[2 * tl]; rs[bj][n][e] = MS[2 * tl + 1]; }
#pragma unroll
        for (int ai = 0; ai < 2; ++ai)
#pragma unroll
            for (int m = 0; m < 4; ++m) { const size_t row = (size_t)(row0 + ai * HALF + m * 16); const float c1 = C1[row], c2 = C2[row];
#pragma unroll
                for (int bj = 0; bj < 2; ++bj) { bf16_t* d = C + row * SCT_LD + colt + bj * HALF;
                    *(u32x4*)d = pack8(rs[bj][0] * (acc[ai][bj][m][0] - mu[bj][0] * c1) + c2, rs[bj][1] * (acc[ai][bj][m][1] - mu[bj][1] * c1) + c2); } }
    }
};
}

DI void tconv_item(const float* __restrict__ src, size_t ld, int c0, bf16_t* __restrict__ dst, int K, int k0, LAS float* tile, int tid) {
    __syncthreads();
    { float v[32]; const float* sp = src + (size_t)(k0 + (tid >> 6)) * ld + c0 + (tid & 63);
#pragma unroll
      for (int i = 0; i < 32; ++i) v[i] = sp[(size_t)(8 * i) * ld];
#pragma unroll
      for (int i = 0; i < 32; ++i) tile[((tid >> 6) + 8 * i) * 65 + (tid & 63)] = v[i]; }
    __syncthreads();
#pragma unroll
    for (int i = 0; i < 4; ++i) { const int idx = tid + 512 * i, rr = idx >> 5, ks = idx & 31;
        float v[8];
#pragma unroll
        for (int j = 0; j < 8; ++j) v[j] = tile[(ks * 8 + j) * 65 + rr];
        *(u32x4*)(dst + (size_t)rr * K + k0 + ks * 8) = (u32x4){pk_bf16(v[0], v[1]), pk_bf16(v[2], v[3]), pk_bf16(v[4], v[5]), pk_bf16(v[6], v[7])}; }
    __syncthreads();
}
constexpr int TC_PER_LAYER = 2560;
DI void tconv_dispatch(const Params& p, int item, LAS float* tile, int tid) {
    const int l = item / TC_PER_LAYER; int it = item % TC_PER_LAYER;
    unsigned char* ws = p.ws;
    if (it < 1792) {
        const int rt = it >> 3, kt = it & 7; int r0 = rt * 64; const float* src = p.in[I_WIN] + (size_t)l * DM * NIN;
        if (rt < 160) { const int col = r0 < 2048 ? r0 : (r0 < 3072 ? r0 + 1024 : r0 + 4112);
            tconv_item(src, NIN, col, (bf16_t*)(ws + O_WIN1) + ((size_t)l * 10240 + r0) * 2048, 2048, kt * 256, tile, tid); }
        else { r0 -= 10240; const int col = r0 < 1024 ? r0 + 2048 : r0 + 3088;
            tconv_item(src, NIN, col, (bf16_t*)(ws + O_WIN2) + ((size_t)l * 4096 + r0) * 2048, 2048, kt * 256, tile, tid); }
        return;
    }
    it -= 1792;
    if (it < 128) { const int rt = it >> 2, kt = it & 3; tconv_item(p.in[I_WMO] + (size_t)l * BW * DM, DM, rt * 64, (bf16_t*)(ws + O_WA) + ((size_t)l * 2048 + rt * 64) * 1024, 1024, kt * 256, tile, tid); return; }
    it -= 128;
    if (it < 128) { const int rt = it >> 2, kt = it & 3; tconv_item(p.in[I_WHO] + (size_t)l * BW * DM, DM, rt * 64, (bf16_t*)(ws + O_WB) + ((size_t)l * 2048 + rt * 64) * 1024, 1024, kt * 256, tile, tid); return; }
    it -= 128;
    if (it < 256) { const int rt = it >> 2, kt = it & 3, r0 = rt * 64, u = r0 >> 8, w = r0 & 255; const int col = w < 128 ? 128 * u + w : 2048 + 128 * u + (w - 128);
        tconv_item(p.in[I_WSG] + (size_t)l * BW * 4096, 4096, col, (bf16_t*)(ws + O_WC) + ((size_t)l * 4096 + r0) * 1024, 1024, kt * 256, tile, tid); return; }
    it -= 256;
    { const int rt = it >> 3, kt = it & 7; tconv_item(p.in[I_WOUT] + (size_t)l * DM * DM, DM, rt * 64, (bf16_t*)(ws + O_WO) + ((size_t)l * 2048 + rt * 64) * 2048, 2048, kt * 256, tile, tid); }
}
DI bf16x8 ld8_bf16(const float* __restrict__ src) { const f32x4 a = *(const f32x4*)src, b = *(const f32x4*)(src + 4);
    return __builtin_bit_cast(bf16x8, (u32x4){pk_bf16(a[0], a[1]), pk_bf16(a[2], a[3]), pk_bf16(b[0], b[1]), pk_bf16(b[2], b[3])}); }
DI void ws_item(const Params& p, int item, int tid) {
    const int l = item >> 8, hc = (item >> 4) & 15, dt = item & 15;
    const int wid = __builtin_amdgcn_readfirstlane(tid >> 6), lane = tid & 63, fr = lane & 15, fq = lane >> 4;
    const float* sk = p.in[I_PSK] + ((size_t)l * 16 + hc) * 16384 + fr * 128 + 8 * fq;
    const float* wq = p.in[I_PWQ] + (size_t)l * DM * DM + (size_t)(128 * dt + 16 * wid + fr) * DM + hc * 128 + 8 * fq;
    f32x4 acc[8];
#pragma unroll
    for (int m = 0; m < 8; ++m) acc[m] = (f32x4){0.f, 0.f, 0.f, 0.f};
#pragma unroll
    for (int ks = 0; ks < 4; ++ks) { const bf16x8 bfr = ld8_bf16(wq + 32 * ks);
#pragma unroll
        for (int m = 0; m < 8; ++m) acc[m] = __builtin_amdgcn_mfma_f32_16x16x32_bf16(ld8_bf16(sk + (16 * m) * 128 + 32 * ks), bfr, acc[m], 0, 0, 0); }
    const int dcol = 128 * dt + 16 * wid + fr;
    const float gam = p.in[I_L1G][l * DM + dcol], bet = p.in[I_L1B][l * DM + dcol];
    bf16_t* dst = (bf16_t*)(p.ws + O_WS) + ((size_t)l * 2048 + hc * 128 + 4 * fq) * 2048 + dcol;
    float* c1p = (float*)(p.ws + O_C1P) + ((size_t)l * 2048 + hc * 128 + 4 * fq) * 128 + dt * 8 + wid;
    float* c2p = (float*)(p.ws + O_C2P) + ((size_t)l * 2048 + hc * 128 + 4 * fq) * 128 + dt * 8 + wid;
#pragma unroll
    for (int m = 0; m < 8; ++m)
#pragma unroll
        for (int j = 0; j < 4; ++j) { const unsigned wb = pk_bf16(acc[m][j] * gam, 0.f) & 0xffffu;
            dst[(size_t)(16 * m + j) * 2048] = (bf16_t)wb;
            float s1 = __uint_as_float(wb << 16), s2 = acc[m][j] * bet;
            s1 += __shfl_xor(s1, 1); s1 += __shfl_xor(s1, 2); s1 += __shfl_xor(s1, 4); s1 += __shfl_xor(s1, 8);
            s2 += __shfl_xor(s2, 1); s2 += __shfl_xor(s2, 2); s2 += __shfl_xor(s2, 4); s2 += __shfl_xor(s2, 8);
            if (fr == 0) { c1p[(size_t)(16 * m + j) * 128] = s1; c2p[(size_t)(16 * m + j) * 128] = s2; } }
}
DI void hid2_item(const Params& p, int item, int lane) {
    const int l = item >> 13, t = item & 8191;
    const float* w1 = p.in[I_HW1] + (size_t)l * 33 * 64; const float* w2 = p.in[I_HW2] + (size_t)l * 64 * 64;
    float cs = 0.f, sn = 0.f;
    { const int i = lane & 15; const double band = 1e-4 + (double)i * ((15.0 - 1e-4) / 15.0); double r = (double)t * band / 8192.0; r -= floor(r);
      const float fr = (float)r; sincospif(2.0f * fr, &sn, &cs); }
    float acc = p.in[I_HB1][l * 64 + lane] + ((float)t / 8191.0f) * w1[lane];
#pragma unroll
    for (int i = 0; i < 16; ++i) { const float c = __shfl(cs, i), s = __shfl(sn, i); acc += c * w1[(1 + i) * 64 + lane] - s * w1[(17 + i) * 64 + lane]; }
    const float h1 = sinf(p.in[I_HFQ][(l * 2 + 0) * 64 + lane] * acc);
    float acc2 = p.in[I_HB2][l * 64 + lane];
#pragma unroll 16
    for (int i = 0; i < 64; ++i) acc2 += __shfl(h1, i) * w2[i * 64 + lane];
    const float h2 = sinf(p.in[I_HFQ][(l * 2 + 1) * 64 + lane] * acc2);
    const float h2n = __shfl_down(h2, 1);
    if ((lane & 1) == 0) ((unsigned*)(p.ws + O_HID2))[(((size_t)l * 8192 + t) * 64 + lane) >> 1] = pk_bf16(h2, h2n);
}

constexpr int FN = 16384;
DI int rev4_14(int k) { unsigned v = __brev((unsigned)k) >> 18; return (int)(((v & 0x2AAAu) >> 1) | ((v & 0x1555u) << 1)); }
DI int SW(int e) { const int h = e >> 5; return e ^ ((h ^ (h << 1)) & 31); }
struct FftTw { cf2 a0[3], b0[3], sa[3], sb[3], a2[3], b2[3], a4[3], b4[3]; };
DI void fft_load_tw(FftTw& t, const cf2* __restrict__ tw, int tid) {
#pragma unroll
    for (int k = 1; k <= 3; ++k) {
        t.a0[k - 1] = tw[tid * k]; t.b0[k - 1] = tw[4 * tid * k]; t.sa[k - 1] = tw[512 * k]; t.sb[k - 1] = tw[2048 * k];
        const int j2 = tid & 63, j4 = tid & 3;
        t.a2[k - 1] = tw[j2 * 16 * k]; t.b2[k - 1] = tw[j2 * 64 * k]; t.a4[k - 1] = tw[j4 * 256 * k]; t.b4[k - 1] = tw[j4 * 1024 * k];
    }
}
DI cf2 cmulk(cf2 z, float cr, float ci) { return mk2(z.x * cr - z.y * ci, z.x * ci + z.y * cr); }
template <int n, bool CONJ> DI cf2 mulw16(cf2 z) {
    constexpr float C1 = 0.9238795325112867f, S1 = 0.3826834323650898f, H = 0.7071067811865476f;
    constexpr float sg = CONJ ? -1.0f : 1.0f;
    if (n == 1) return cmulk(z, C1, -S1 * sg);
    if (n == 2) return cmulk(z, H, -H * sg);
    if (n == 3) return cmulk(z, S1, -C1 * sg);
    if (n == 4) return CONJ ? mk2(-z.y, z.x) : mk2(z.y, -z.x);
    if (n == 6) return cmulk(z, -H, -H * sg);
    return cmulk(z, -C1, S1 * sg);
}
DI void bfly_f(cf2& x0, cf2& x1, cf2& x2, cf2& x3) {
    const cf2 a0 = x0 + x2, a1 = x0 - x2, a2 = x1 + x3, a3 = x1 - x3;
    x0 = a0 + a2; x2 = a0 - a2; x1 = mk2(a1.x + a3.y, a1.y - a3.x); x3 = mk2(a1.x - a3.y, a1.y + a3.x);
}
DI void bfly_i(cf2& u0, cf2& u1, cf2& u2, cf2& u3) {
    const cf2 b0 = u0 + u2, b1 = u0 - u2, b2 = u1 + u3, b3 = u1 - u3;
    u0 = b0 + b2; u2 = b0 - b2; u1 = mk2(b1.x - b3.y, b1.y + b3.x); u3 = mk2(b1.x + b3.y, b1.y - b3.x);
}
template <int P, bool INV>
DI void fft_pass16(LAS cf2* x, const FftTw& tw, int tid) {
    constexpr int lq1 = 12 - 2 * (P + 1), q1 = 1 << lq1, q0 = 4 * q1;
    cf2 wa[3], wb[3];
#pragma unroll
    for (int k = 0; k < 3; ++k) { wa[k] = P == 0 ? tw.a0[k] : (P == 2 ? tw.a2[k] : tw.a4[k]); wb[k] = P == 0 ? tw.b0[k] : (P == 2 ? tw.b2[k] : tw.b4[k]); }
#pragma unroll 1
    for (int i = 0; i < 2; ++i) {
        const int gp = tid + 512 * i, jp = gp & (q1 - 1), base = ((gp >> lq1) << (lq1 + 4)) + jp;
        cf2 t[4][4];
#pragma unroll
        for (int m1 = 0; m1 < 4; ++m1)
#pragma unroll
            for (int m2 = 0; m2 < 4; ++m2) t[m1][m2] = x[SW(base + m1 * q0 + m2 * q1)];
        if (!INV) {
#pragma unroll
            for (int m2 = 0; m2 < 4; ++m2) { bfly_f(t[0][m2], t[1][m2], t[2][m2], t[3][m2]);
                t[1][m2] = cmul(t[1][m2], wa[0]); t[2][m2] = cmul(t[2][m2], wa[1]); t[3][m2] = cmul(t[3][m2], wa[2]); }
            t[1][1] = mulw16<1, false>(t[1][1]); t[2][1] = mulw16<2, false>(t[2][1]); t[3][1] = mulw16<3, false>(t[3][1]);
            t[1][2] = mulw16<2, false>(t[1][2]); t[2][2] = mulw16<4, false>(t[2][2]); t[3][2] = mulw16<6, false>(t[3][2]);
            t[1][3] = mulw16<3, false>(t[1][3]); t[2][3] = mulw16<6, false>(t[2][3]); t[3][3] = mulw16<9, false>(t[3][3]);
#pragma unroll
            for (int k1 = 0; k1 < 4; ++k1) { bfly_f(t[k1][0], t[k1][1], t[k1][2], t[k1][3]);
                t[k1][1] = cmul(t[k1][1], wb[0]); t[k1][2] = cmul(t[k1][2], wb[1]); t[k1][3] = cmul(t[k1][3], wb[2]); }
        } else {
#pragma unroll
            for (int k1 = 0; k1 < 4; ++k1) { t[k1][1] = cmulc(t[k1][1], wb[0]); t[k1][2] = cmulc(t[k1][2], wb[1]); t[k1][3] = cmulc(t[k1][3], wb[2]);
                bfly_i(t[k1][0], t[k1][1], t[k1][2], t[k1][3]); }
            t[1][1] = mulw16<1, true>(t[1][1]); t[2][1] = mulw16<2, true>(t[2][1]); t[3][1] = mulw16<3, true>(t[3][1]);
            t[1][2] = mulw16<2, true>(t[1][2]); t[2][2] = mulw16<4, true>(t[2][2]); t[3][2] = mulw16<6, true>(t[3][2]);
            t[1][3] = mulw16<3, true>(t[1][3]); t[2][3] = mulw16<6, true>(t[2][3]); t[3][3] = mulw16<9, true>(t[3][3]);
#pragma unroll
            for (int m2 = 0; m2 < 4; ++m2) { t[1][m2] = cmulc(t[1][m2], wa[0]); t[2][m2] = cmulc(t[2][m2], wa[1]); t[3][m2] = cmulc(t[3][m2], wa[2]);
                bfly_i(t[0][m2], t[1][m2], t[2][m2], t[3][m2]); }
        }
#pragma unroll
        for (int m1 = 0; m1 < 4; ++m1)
#pragma unroll
            for (int m2 = 0; m2 < 4; ++m2) x[SW(base + m1 * q0 + m2 * q1)] = t[m1][m2];
        if (P == 0) {
#pragma unroll
            for (int k = 0; k < 3; ++k) { wa[k] = cmul(wa[k], tw.sa[k]); wb[k] = cmul(wb[k], tw.sb[k]); }
        }
    }
    __syncthreads();
}
template <bool INV>
DI void fft_pass4_last(LAS cf2* x, int tid) {
#pragma unroll 4
    for (int i = 0; i < 8; ++i) { const int b4 = 4 * (tid + 512 * i);
        const int e0 = SW(b4), e1 = SW(b4 + 1), e2 = SW(b4 + 2), e3 = SW(b4 + 3);
        cf2 x0 = x[e0], x1 = x[e1], x2 = x[e2], x3 = x[e3];
        if (!INV) bfly_f(x0, x1, x2, x3); else bfly_i(x0, x1, x2, x3);
        x[e0] = x0; x[e1] = x1; x[e2] = x2; x[e3] = x3; }
    __syncthreads();
}
DI void fft_fwd(LAS cf2* x, const FftTw& t, int tid) { fft_pass16<0, false>(x, t, tid); fft_pass16<2, false>(x, t, tid); fft_pass16<4, false>(x, t, tid); fft_pass4_last<false>(x, tid); }
DI void fft_inv(LAS cf2* x, const FftTw& t, int tid) { fft_pass4_last<true>(x, tid); fft_pass16<4, true>(x, t, tid); fft_pass16<2, true>(x, t, tid); fft_pass16<0, true>(x, t, tid); }
DI void ftap_item(const Params& p, int item, int tid) {
    const int l = item >> 6, ct = item & 63, wid = __builtin_amdgcn_readfirstlane(tid >> 6), lane = tid & 63, fr = lane & 15, fq = lane >> 4;
    bf16x8 wh[2][2], wl[2][2];
#pragma unroll
    for (int c2 = 0; c2 < 2; ++c2) { const float* w3 = p.in[I_HW3] + (size_t)l * 64 * 2048 + ct * 32 + 16 * c2 + fr;
#pragma unroll
        for (int ks = 0; ks < 2; ++ks) { float v[8]; u32x4 h, lo;
#pragma unroll
            for (int j = 0; j < 8; ++j) v[j] = w3[(size_t)(32 * ks + 8 * fq + j) * 2048];
#pragma unroll
            for (int e = 0; e < 4; ++e) { h[e] = pk_bf16(v[2 * e], v[2 * e + 1]); lo[e] = pk_bf16(v[2 * e] - bf_lo(h[e]), v[2 * e + 1] - bf_hi(h[e])); }
            wh[c2][ks] = __builtin_bit_cast(bf16x8, h); wl[c2][ks] = __builtin_bit_cast(bf16x8, lo); } }
    const bf16_t* hid = (const bf16_t*)(p.ws + O_HID2) + ((size_t)l * 8192 + 1024 * wid + fr) * 64 + 8 * fq;
    float* ft = (float*)(p.ws + O_FT) + ((size_t)l * 2048 + ct * 32 + fr) * 8192 + 1024 * wid + 4 * fq;
#pragma unroll 4
    for (int i = 0; i < 64; ++i) {
        const bf16x8 a0 = *(const bf16x8*)(hid + (size_t)(16 * i) * 64), a1 = *(const bf16x8*)(hid + (size_t)(16 * i) * 64 + 32);
#pragma unroll
        for (int c2 = 0; c2 < 2; ++c2) { f32x4 acc = (f32x4){0.f, 0.f, 0.f, 0.f};
            acc = __builtin_amdgcn_mfma_f32_16x16x32_bf16(a0, wh[c2][0], acc, 0, 0, 0); acc = __builtin_amdgcn_mfma_f32_16x16x32_bf16(a0, wl[c2][0], acc, 0, 0, 0);
            acc = __builtin_amdgcn_mfma_f32_16x16x32_bf16(a1, wh[c2][1], acc, 0, 0, 0); acc = __builtin_amdgcn_mfma_f32_16x16x32_bf16(a1, wl[c2][1], acc, 0, 0, 0);
            *(f32x4*)(ft + (size_t)(16 * c2) * 8192 + 16 * i) = acc; }
    }
}
DI void filt_item(const Params& p, int item, LAS unsigned char* lds, int tid) {
    __syncthreads();
    const int l = item >> 9, pr = item & 511, c1 = 2 * pr;
    LAS cf2* buf = (LAS cf2*)lds; LAS float* red = (LAS float*)(lds + 131072);
    const cf2* tw = (const cf2*)(p.ws + O_TW);
    FftTw ftw; fft_load_tw(ftw, tw, tid);
    const int q = tid >> 7, tl = tid & 127, wid = __builtin_amdgcn_readfirstlane(tid >> 6);
    const float dec = fabsf(p.in[I_HDC][((size_t)l * 2 + (q >> 1)) * 1024 + c1 + (q & 1)]);
    const float* ftc = (const float*)(p.ws + O_FT) + ((size_t)l * 2048 + (q >> 1) * 1024 + c1 + (q & 1)) * 8192 + 4 * tl;
    float we[4];
#pragma unroll
    for (int e = 0; e < 4; ++e) we[e] = expf(-((float)(4 * tl + e) / 8191.0f) * dec);
    const float wstep = expf(-(512.0f / 8191.0f) * dec);
    float wt = 1.0f, asum = 0.f;
    LAS float* bufs = (LAS float*)buf;
#pragma unroll 4
    for (int i = 0; i < 16; ++i) { const int t0 = 4 * tl + 512 * i; const f32x4 fv = *(const f32x4*)(ftc + 512 * i);
#pragma unroll
        for (int e = 0; e < 4; ++e) { const int t = t0 + e; const float f = fv[e] * (wt * we[e]); asum += fabsf(f);
            if (q < 2) bufs[2 * SW(t) + q] = f; else if (t >= 1) bufs[2 * SW(FN - t) + (q - 2)] = f; }
        wt *= wstep; }
    if (tid == 0) buf[SW(8192)] = mk2(0.f, 0.f);
    { const float sq = wave_sum(asum); if ((tid & 63) == 0) red[wid] = sq; }
    __syncthreads();
    float sc[4];
#pragma unroll
    for (int qq = 0; qq < 4; ++qq) sc[qq] = 1.0f / (red[2 * qq] + red[2 * qq + 1] + 1e-6f);
#pragma unroll 2
    for (int i = 0; i < 32; ++i) { const int n = tid + 512 * i; cf2 v = buf[SW(n)]; if (n < 8192) { v.x *= sc[0]; v.y *= sc[1]; } else { v.x *= sc[2]; v.y *= sc[3]; } buf[SW(n)] = v; }
    __syncthreads();
    fft_fwd(buf, ftw, tid);
    f32x4* pm = (f32x4*)(p.ws + O_PM) + ((size_t)l * 512 + pr) * PM_STRIDE;
    const float inv = 1.0f / (2.0f * 16384.0f);
#pragma unroll 1
    for (int i = 0; i < 17; ++i) { const int k = tid + 512 * i; if (k > 8192) break;
        const cf2 A = buf[SW(rev4_14(k))], B = buf[SW(rev4_14((FN - k) & (FN - 1)))];
        const float h1x = 0.5f * (A.x + B.x), h1y = 0.5f * (A.y - B.y), h2x = 0.5f * (A.y + B.y), h2y = -0.5f * (A.x - B.x);
        pm[k] = (f32x4){(h1x + h2x) * inv, (h1y + h2y) * inv, (h1x - h2x) * inv, (h1y - h2y) * inv}; }
    __syncthreads();
}
DI void conv3x8(const bf16_t* __restrict__ row, int t0, float w0, float w1, float w2, float b, float (&o)[8]) {
    const u32x4 cw = *(const u32x4*)(row + t0);
    float c[10];
    c[0] = t0 > 0 ? __uint_as_float(((unsigned)row[t0 - 1]) << 16) : 0.f;
    c[9] = t0 + 8 < T ? __uint_as_float(((unsigned)row[t0 + 8]) << 16) : 0.f;
#pragma unroll
    for (int e = 0; e < 4; ++e) { c[1 + 2 * e] = bf_lo(cw[e]); c[2 + 2 * e] = bf_hi(cw[e]); }
#pragma unroll
    for (int e = 0; e < 8; ++e) o[e] = w0 * c[e] + w1 * c[e + 1] + w2 * c[e + 2] + b;
}
DI void hyena_item(const Params& p, int l, int pr, LAS unsigned char* lds, int tid) {
    __syncthreads();
    LAS cf2* buf = (LAS cf2*)lds;
    const cf2* tw = (const cf2*)(p.ws + O_TW);
    FftTw ftw; fft_load_tw(ftw, tw, tid);
    const bf16_t* hpt = (const bf16_t*)(p.ws + O_HPT);
    const float* cw = p.in[I_HCW] + (size_t)l * 3 * 3072; const float* cb = p.in[I_HCB] + (size_t)l * 3072;
    const int c1 = 2 * pr;
    float w[6][4];
#pragma unroll
    for (int s = 0; s < 3; ++s)
#pragma unroll
        for (int e = 0; e < 2; ++e) { const int ch = s * 1024 + c1 + e; w[s * 2 + e][0] = cw[ch]; w[s * 2 + e][1] = cw[3072 + ch]; w[s * 2 + e][2] = cw[6144 + ch]; w[s * 2 + e][3] = cb[ch]; }
    const bf16_t* r_x0a = hpt + (size_t)(c1) * T;        const bf16_t* r_x0b = r_x0a + T;
    const bf16_t* r_x1a = hpt + (size_t)(1024 + c1) * T; const bf16_t* r_x1b = r_x1a + T;
    const bf16_t* r_va  = hpt + (size_t)(2048 + c1) * T; const bf16_t* r_vb  = r_va + T;
#pragma unroll 1
    for (int i = 0; i < 2; ++i) { const int t0 = 8 * tid + 4096 * i;
        float xa[8], va[8], xb[8], vb[8];
        conv3x8(r_x1a, t0, w[2][0], w[2][1], w[2][2], w[2][3], xa); conv3x8(r_va, t0, w[4][0], w[4][1], w[4][2], w[4][3], va);
        conv3x8(r_x1b, t0, w[3][0], w[3][1], w[3][2], w[3][3], xb); conv3x8(r_vb, t0, w[5][0], w[5][1], w[5][2], w[5][3], vb);
#pragma unroll
        for (int e = 0; e < 8; ++e) { buf[SW(t0 + e)] = mk2(xa[e] * va[e], xb[e] * vb[e]); buf[SW(t0 + e + 8192)] = mk2(0.f, 0.f); } }
    __syncthreads();
    fft_fwd(buf, ftw, tid);
    const f32x4* pm = (const f32x4*)(p.ws + O_PM) + ((size_t)l * 512 + pr) * PM_STRIDE;
#pragma unroll 4
    for (int i = 0; i < 16; ++i) { const int k = tid + 512 * i;
        const int pk = SW(rev4_14(k)), pnk = SW(rev4_14((FN - k) & (FN - 1)));
        const cf2 A = buf[pk], B = buf[pnk]; const f32x4 PMv = pm[k];
        const cf2 P = mk2(PMv[0], PMv[1]), M = mk2(PMv[2], PMv[3]);
        const cf2 Yk = mk2(A.x * P.x - A.y * P.y + B.x * M.x + B.y * M.y, A.x * P.y + A.y * P.x + B.x * M.y - B.y * M.x);
        const cf2 Yn = mk2(B.x * P.x + B.y * P.y + A.x * M.x - A.y * M.y, B.y * P.x - B.x * P.y - A.x * M.y - A.y * M.x);
        buf[pk] = Yk; if (pnk != pk) buf[pnk] = Yn; }
    if (tid == 0) { const int pk = SW(rev4_14(8192)); const cf2 A = buf[pk]; const f32x4 PMv = pm[8192];
        buf[pk] = mk2(A.x * PMv[0] - A.y * PMv[1] + A.x * PMv[2] + A.y * PMv[3], A.x * PMv[1] + A.y * PMv[0] + A.x * PMv[3] - A.y * PMv[2]); }
    __syncthreads();
    fft_inv(buf, ftw, tid);
    const float ska = p.in[I_HSK][l * 1024 + c1], skb = p.in[I_HSK][l * 1024 + c1 + 1];
    bf16_t* yht = (bf16_t*)(p.ws + O_KT);
#pragma unroll 1
    for (int i = 0; i < 2; ++i) { const int t0 = 8 * tid + 4096 * i;
        float xa[8], va[8], xb[8], vb[8], ga[8], gb[8];
        conv3x8(r_x1a, t0, w[2][0], w[2][1], w[2][2], w[2][3], xa); conv3x8(r_va, t0, w[4][0], w[4][1], w[4][2], w[4][3], va);
        conv3x8(r_x1b, t0, w[3][0], w[3][1], w[3][2], w[3][3], xb); conv3x8(r_vb, t0, w[5][0], w[5][1], w[5][2], w[5][3], vb);
        conv3x8(r_x0a, t0, w[0][0], w[0][1], w[0][2], w[0][3], ga); conv3x8(r_x0b, t0, w[1][0], w[1][1], w[1][2], w[1][3], gb);
        float oa[8], ob[8];
#pragma unroll
        for (int e = 0; e < 8; ++e) { const cf2 y = buf[SW(t0 + e)]; oa[e] = ga[e] * (y.x + ska * xa[e] * va[e]); ob[e] = gb[e] * (y.y + skb * xb[e] * vb[e]); }
        *(u32x4*)(yht + (size_t)c1 * T + t0) = (u32x4){pk_bf16(oa[0], oa[1]), pk_bf16(oa[2], oa[3]), pk_bf16(oa[4], oa[5]), pk_bf16(oa[6], oa[7])};
        *(u32x4*)(yht + (size_t)(c1 + 1) * T + t0) = (u32x4){pk_bf16(ob[0], ob[1]), pk_bf16(ob[2], ob[3]), pk_bf16(ob[4], ob[5]), pk_bf16(ob[6], ob[7])}; }
    __syncthreads();
}
DI void yh_transpose_item(const Params& p, int item, LAS unsigned char* lds, int tid) {
    __syncthreads();
    const int c0 = (item & 15) * 64, t0 = (item >> 4) * 64;
    LAS bf16_t* tile = (LAS bf16_t*)lds;
    { const int c = tid >> 3, seg = tid & 7;
      *(LAS u32x4*)(tile + c * 72 + 8 * seg) = *(const u32x4*)((const bf16_t*)(p.ws + O_KT) + (size_t)(c0 + c) * T + t0 + 8 * seg); }
    __syncthreads();
    { const int t = tid >> 3, seg = tid & 7; unsigned w[4];
#pragma unroll
      for (int j = 0; j < 4; ++j) w[j] = (unsigned)tile[(8 * seg + 2 * j) * 72 + t] | ((unsigned)tile[(8 * seg + 2 * j + 1) * 72 + t] << 16);
      *(u32x4*)((bf16_t*)(p.ws + O_YH) + (size_t)(t0 + t) * 1024 + c0 + 8 * seg) = (u32x4){w[0], w[1], w[2], w[3]}; }
}

constexpr int MC_KS = 528, MC_VS = 272, MC_PS = 272;
DI float mlstm_gates(const Params& p, int l, int dir, int head, int t_base, LAS float* li, LAS float* bb, int lane) {
    const float* MG = (const float*)(p.ws + O_MG); const float* bias = p.in[I_MGB] + l * 16;
    float lfv[2], liv[2];
#pragma unroll
    for (int u = 0; u < 2; ++u) { const int r = 2 * lane + u, rho = dir ? 127 - r : r, t = t_base + rho;
        const float gi = MG[t * 16 + dir * 8 + head] + bias[dir * 8 + head], gf = MG[t * 16 + dir * 8 + 4 + head] + bias[dir * 8 + 4 + head];
        liv[u] = gi; lfv[u] = fminf(gf, 0.f) - log1pf(expf(-fabsf(gf))); }
    const float s1 = lfv[0] + lfv[1];
    const float inc = wave_scan_add(s1, lane), exc = inc - s1;
    bb[2 * lane] = exc + lfv[0]; bb[2 * lane + 1] = inc; li[2 * lane] = liv[0]; li[2 * lane + 1] = liv[1];
    return inc;
}
DI u32x4 tr_read2(unsigned a0, unsigned a1) { u32x2 lo, hi;
    asm volatile("ds_read_b64_tr_b16 %0, %2\n\tds_read_b64_tr_b16 %1, %3\n\ts_waitcnt lgkmcnt(0)" : "=&v"(lo), "=&v"(hi) : "v"(a0), "v"(a1) : "memory");
    return (u32x4){lo[0], lo[1], hi[0], hi[1]}; }
DI void mlstm_passA(const Params& p, int l, int item, LAS unsigned char* lds, int tid) {
    __syncthreads();
    const int dir = item >> 8, head = (item >> 6) & 3, cv = item & 63, cact = dir ? 63 - cv : cv, t_base = cact * 128;
    const int wid = __builtin_amdgcn_readfirstlane(tid >> 6), lane = tid & 63;
    LAS unsigned char* Kl = lds;
    LAS float* li = (LAS float*)(lds + 128 * MC_KS); LAS float* bb = li + 128; LAS float* wact = bb + 128;
    if (wid == 0) {
        const float inc = mlstm_gates(p, l, dir, head, t_base, li, bb, lane);
        const float blast = __shfl(inc, 63);
        const float lw0 = blast - bb[2 * lane] + li[2 * lane], lw1 = blast - bb[2 * lane + 1] + li[2 * lane + 1];
        const float ml = wave_max(fmaxf(lw0, lw1));
        const int r0 = 2 * lane, r1 = 2 * lane + 1;
        wact[dir ? 127 - r0 : r0] = expf(lw0 - ml); wact[dir ? 127 - r1 : r1] = expf(lw1 - ml);
        if (lane == 0) { ((float*)(p.ws + O_MLOC))[item] = ml; ((float*)(p.ws + O_BLAST))[item] = blast; }
    }
    { const bf16_t* Kg = (const bf16_t*)(p.ws + O_K) + (size_t)t_base * 1024 + head * 256;
#pragma unroll
      for (int i = 0; i < 8; ++i) { const int idx = tid + 512 * i, rho = idx >> 5, c16 = idx & 31;
          *(LAS u32x4*)(Kl + rho * MC_KS + c16 * 16) = *(const u32x4*)(Kg + (size_t)rho * 1024 + c16 * 8); } }
    __syncthreads();
    const bf16_t* VT = (const bf16_t*)(p.ws + O_VT) + (size_t)head * 256 * T + t_base;
    const int wr = wid >> 1, wc = wid & 1, rl = lane & 15, g = lane >> 4;
    const unsigned kbase = (unsigned)(size_t)Kl + (unsigned)((8 * g + (rl >> 2)) * MC_KS + (128 * wc + 4 * (rl & 3)) * 2);
    f32x4 acc[4][8];
#pragma unroll
    for (int a = 0; a < 4; ++a)
#pragma unroll
        for (int b = 0; b < 8; ++b) acc[a][b] = (f32x4){0.f, 0.f, 0.f, 0.f};
#pragma unroll 1
    for (int ks = 0; ks < 4; ++ks) {
        const int rho0 = 32 * ks + 8 * g;
        float wv[8];
#pragma unroll
        for (int j = 0; j < 8; ++j) wv[j] = wact[rho0 + j];
        bf16x8 af[4];
#pragma unroll
        for (int mt = 0; mt < 4; ++mt) af[mt] = *(const bf16x8*)(VT + (size_t)(64 * wr + 16 * mt + rl) * T + rho0);
#pragma unroll
        for (int nt = 0; nt < 8; ++nt) {
            const unsigned a0 = kbase + (unsigned)(32 * ks * MC_KS + 32 * nt);
            const u32x4 kw = tr_read2(a0, a0 + 4 * MC_KS);
            u32x4 sw;
#pragma unroll
            for (int q = 0; q < 4; ++q) sw[q] = pk_bf16(bf_lo(kw[q]) * wv[2 * q], bf_hi(kw[q]) * wv[2 * q + 1]);
            const bf16x8 bfr = __builtin_bit_cast(bf16x8, sw);
#pragma unroll
            for (int mt = 0; mt < 4; ++mt) acc[mt][nt] = __builtin_amdgcn_mfma_f32_16x16x32_bf16(bfr, af[mt], acc[mt][nt], 0, 0, 0);
        }
    }
    bf16_t* KVu = (bf16_t*)(p.ws + O_KV) + (size_t)item * 65536 + (64 * wr) * 256 + 128 * wc;
    const int loff = rl * 256 + 4 * g;
#pragma unroll
    for (int mt = 0; mt < 4; ++mt) { bf16_t* rowp = KVu + (16 * mt) * 256;
#pragma unroll
        for (int nt = 0; nt < 8; ++nt) *(u32x2*)(rowp + loff + 16 * nt) = (u32x2){pk_bf16(acc[mt][nt][0], acc[mt][nt][1]), pk_bf16(acc[mt][nt][2], acc[mt][nt][3])}; }
    if (tid < 256) { float s = 0.f;
#pragma unroll 8
        for (int rho = 0; rho < 128; ++rho) s += wact[rho] * __uint_as_float(((unsigned)*(const LAS bf16_t*)(Kl + rho * MC_KS + 2 * tid)) << 16);
        ((float*)(p.ws + O_NLOC))[(size_t)item * 256 + tid] = s; }
    __syncthreads();
}
DI void mlstm_passB(const Params& p, int gtid, int gthreads, int bid, int tid) {
    const float* MLOC = (const float*)(p.ws + O_MLOC); const float* BLAST = (const float*)(p.ws + O_BLAST);
    if (tid >= 64 && tid < 66 && bid * 2 + (tid - 64) < 512) {
        const int v = bid * 2 + (tid - 64), dh = v >> 6, off = (v & 63) * 4;
        const float* NL_ = (const float*)(p.ws + O_NLOC) + (size_t)dh * 64 * 256 + off;
        float* NST = (float*)(p.ws + O_NST) + (size_t)dh * 64 * 256 + off;
        f32x4 n = (f32x4){0.f, 0.f, 0.f, 0.f}; float m = 0.f;
#pragma unroll 1
        for (int c0 = 0; c0 < 64; c0 += 16) {
            f32x4 nl[16]; float bl[16], ml[16];
#pragma unroll
            for (int k = 0; k < 16; ++k) { nl[k] = *(const f32x4*)(NL_ + (size_t)(c0 + k) * 256); bl[k] = BLAST[dh * 64 + c0 + k]; ml[k] = MLOC[dh * 64 + c0 + k]; }
#pragma unroll
            for (int k = 0; k < 16; ++k) { const int c = c0 + k;
                *(f32x4*)(NST + (size_t)c * 256) = n;
                if (off == 0) ((float*)(p.ws + O_MST))[dh * 64 + c] = m;
                const float mn = fmaxf(bl[k] + m, ml[k]);
                n = expf(bl[k] + m - mn) * n + expf(ml[k] - mn) * nl[k]; m = mn; }
        }
    }
    for (int w = gtid; w < 8 * 16384; w += gthreads) {
        const int dh = w >> 14, off = (w & 16383) * 4;
        const bf16_t* KV = (const bf16_t*)(p.ws + O_KV) + (size_t)dh * 64 * 65536 + off;
        bf16_t* CST = (bf16_t*)(p.ws + O_CST) + (size_t)dh * 64 * 65536 + off;
        f32x4 C = (f32x4){0.f, 0.f, 0.f, 0.f}; float m = 0.f;
#pragma unroll 1
        for (int c0 = 0; c0 < 64; c0 += 16) {
            u32x2 kw[16];
#pragma unroll
            for (int k = 0; k < 16; ++k) kw[k] = *(const u32x2*)(KV + (size_t)(c0 + k) * 65536);
#pragma unroll
            for (int k = 0; k < 16; ++k) { const int c = c0 + k; const f32x4 kv = (f32x4){bf_lo(kw[k][0]), bf_hi(kw[k][0]), bf_lo(kw[k][1]), bf_hi(kw[k][1])};
                *(u32x2*)(CST + (size_t)c * 65536) = (u32x2){pk_bf16(C[0], C[1]), pk_bf16(C[2], C[3])};
                const float bl = BLAST[dh * 64 + c], ml = MLOC[dh * 64 + c], mn = fmaxf(bl + m, ml);
                const float dk = expf(bl + m - mn), sk = expf(ml - mn);
                C = dk * C + sk * kv; m = mn; }
        }
    }
}
DI void mlstm_passC(const Params& p, int l, int item, LAS unsigned char* lds, int tid) {
    __syncthreads();
    const int dir = item >> 8, head = (item >> 6) & 3, cv = item & 63, cact = dir ? 63 - cv : cv, t_base = cact * 128;
    const int wid = __builtin_amdgcn_readfirstlane(tid >> 6), lane = tid & 63, rl = lane & 15, g = lane >> 4;
    constexpr int RA = 256 * MC_VS;
    LAS unsigned char* Kl = lds;
    LAS unsigned char* Vl = lds;
    LAS unsigned char* Pw = lds + RA + wid * 16 * MC_PS;
    LAS float* sc = (LAS float*)(lds + 2 * RA);
    LAS float* li = sc; LAS float* bb = sc + 128; LAS float* av = sc + 256; LAS float* Mx = sc + 384; LAS float* inter = sc + 512; LAS float* en = sc + 640;
    LAS float* nst = sc + 768; LAS float* qn = sc + 1024;
    const float mstate = ((const float*)(p.ws + O_MST))[item];
    if (wid == 0) {
        mlstm_gates(p, l, dir, head, t_base, li, bb, lane);
        const float a0 = li[2 * lane] - bb[2 * lane], a1 = li[2 * lane + 1] - bb[2 * lane + 1];
        const float pm = fmaxf(a0, a1), inc = wave_scan_max(pm, lane);
        float exc = __shfl_up(inc, 1); if (lane == 0) exc = -3.0e38f;
        const float M0 = fmaxf(mstate, fmaxf(exc, a0)), M1 = fmaxf(mstate, inc);
        av[2 * lane] = a0; av[2 * lane + 1] = a1; Mx[2 * lane] = M0; Mx[2 * lane + 1] = M1;
        inter[2 * lane] = expf(mstate - M0); inter[2 * lane + 1] = expf(mstate - M1);
        en[2 * lane] = expf(-(bb[2 * lane] + M0)); en[2 * lane + 1] = expf(-(bb[2 * lane + 1] + M1));
    }
    {
        const bf16_t* Kg = (const bf16_t*)(p.ws + O_K) + head * 256;
#pragma unroll
        for (int i = 0; i < 8; ++i) { const int idx = tid + 512 * i, s = idx >> 5, c16 = idx & 31; const int t = t_base + (dir ? 127 - s : s);
            *(LAS u32x4*)(Kl + s * MC_KS + c16 * 16) = *(const u32x4*)(Kg + (size_t)t * 1024 + c16 * 8); }
        if (tid < 256) nst[tid] = ((const float*)(p.ws + O_NST))[(size_t)item * 256 + tid];
    }
    __syncthreads();
    bf16x8 qa[8];
    { const int r = 16 * wid + rl, t = t_base + (dir ? 127 - r : r); const bf16_t* qr = (const bf16_t*)(p.ws + O_Q) + (size_t)t * 1024 + head * 256 + 8 * g;
#pragma unroll
      for (int kk = 0; kk < 8; ++kk) qa[kk] = *(const bf16x8*)(qr + 32 * kk); }
    { float s = 0.f;
#pragma unroll
      for (int kk = 0; kk < 8; ++kk) { const u32x4 w = __builtin_bit_cast(u32x4, qa[kk]);
#pragma unroll
          for (int e = 0; e < 4; ++e) s += bf_lo(w[e]) * nst[32 * kk + 8 * g + 2 * e] + bf_hi(w[e]) * nst[32 * kk + 8 * g + 2 * e + 1]; }
      s += __shfl_xor(s, 16); s += __shfl_xor(s, 32);
      if (g == 0) qn[wid * 16 + rl] = s; }
    float rs[4] = {0.f, 0.f, 0.f, 0.f};
    float Mr[4], ir[4];
#pragma unroll
    for (int j = 0; j < 4; ++j) { Mr[j] = Mx[16 * wid + 4 * g + j]; ir[j] = inter[16 * wid + 4 * g + j]; }
#pragma unroll
    for (int nt = 0; nt < 8; ++nt) if (nt <= wid + 1) {
        f32x4 st = (f32x4){0.f, 0.f, 0.f, 0.f};
        if (nt <= wid) {
#pragma unroll
            for (int kk = 0; kk < 8; ++kk) st = __builtin_amdgcn_mfma_f32_16x16x32_bf16(qa[kk], *(const LAS bf16x8*)(Kl + (16 * nt + rl) * MC_KS + kk * 64 + g * 16), st, 0, 0, 0);
            const int s = 16 * nt + rl; const float as = av[s];
#pragma unroll
            for (int j = 0; j < 4; ++j) { const int r = 16 * wid + 4 * g + j; const float v = (s <= r) ? st[j] * expf(as - Mr[j]) : 0.f; st[j] = v; rs[j] += v; }
        }
#pragma unroll
        for (int j = 0; j < 4; ++j) *(LAS bf16_t*)(Pw + (4 * g + j) * MC_PS + (16 * nt + rl) * 2) = (bf16_t)(pk_bf16(st[j], 0.f) & 0xffffu);
    }
#pragma unroll
    for (int j = 0; j < 4; ++j) { float v = rs[j]; v += __shfl_xor(v, 1); v += __shfl_xor(v, 2); v += __shfl_xor(v, 4); v += __shfl_xor(v, 8); rs[j] = v; }
    f32x4 acc[16];
    const bf16_t* CST = (const bf16_t*)(p.ws + O_CST) + (size_t)item * 65536;
#pragma unroll
    for (int hf = 0; hf < 2; ++hf) {
        __syncthreads();
#pragma unroll
        for (int i = 0; i < 8; ++i) { const int idx = tid + 512 * i, e = idx >> 5, c16 = idx & 31;
            *(LAS u32x4*)(Kl + e * MC_KS + c16 * 16) = *(const u32x4*)(CST + (size_t)(128 * hf + e) * 256 + c16 * 8); }
        __syncthreads();
#pragma unroll
        for (int n8 = 0; n8 < 8; ++n8) { const int n2 = 8 * hf + n8;
            acc[n2] = (f32x4){0.f, 0.f, 0.f, 0.f};
#pragma unroll
            for (int kk = 0; kk < 8; ++kk) acc[n2] = __builtin_amdgcn_mfma_f32_16x16x32_bf16(qa[kk], *(const LAS bf16x8*)(Kl + (16 * n8 + rl) * MC_KS + kk * 64 + g * 16), acc[n2], 0, 0, 0);
#pragma unroll
            for (int j = 0; j < 4; ++j) acc[n2][j] *= ir[j];
        }
    }
    __syncthreads();
    {
        const bf16_t* VT = (const bf16_t*)(p.ws + O_VT) + (size_t)head * 256 * T + t_base;
#pragma unroll
        for (int i = 0; i < 8; ++i) { const int idx = tid + 512 * i, e = idx >> 4, seg = idx & 15;
            u32x4 v = *(const u32x4*)(VT + (size_t)e * T + 8 * seg); int s0 = 8 * seg;
            if (dir) { v = (u32x4){__builtin_rotateleft32(v[3], 16), __builtin_rotateleft32(v[2], 16), __builtin_rotateleft32(v[1], 16), __builtin_rotateleft32(v[0], 16)}; s0 = 120 - 8 * seg; }
            *(LAS u32x4*)(Vl + e * MC_VS + s0 * 2) = v; }
    }
    __syncthreads();
    const int nks = (wid >> 1) + 1;
#pragma unroll
    for (int ks = 0; ks < 4; ++ks) if (ks < nks) {
        const bf16x8 pa = *(const LAS bf16x8*)(Pw + rl * MC_PS + ks * 64 + g * 16);
#pragma unroll
        for (int n2 = 0; n2 < 16; ++n2) acc[n2] = __builtin_amdgcn_mfma_f32_16x16x32_bf16(pa, *(const LAS bf16x8*)(Vl + (16 * n2 + rl) * MC_VS + ks * 64 + g * 16), acc[n2], 0, 0, 0);
    }
    float* HD = (float*)(p.ws + O_HDIR) + (size_t)dir * T * 1024 + head * 256;
#pragma unroll
    for (int j = 0; j < 4; ++j) { const int r = 16 * wid + 4 * g + j, t = t_base + (dir ? 127 - r : r);
        const float den = rs[j] + ir[j] * qn[wid * 16 + 4 * g + j]; const float dd = 1.0f / fmaxf(fabsf(den), en[r]);
#pragma unroll
        for (int n2 = 0; n2 < 16; ++n2) HD[(size_t)t * 1024 + 16 * n2 + rl] = acc[n2][j] * dd; }
    __syncthreads();
}
DI void mlstm_final(const Params& p, int l, int t, int lane) {
    const float* h0 = (const float*)(p.ws + O_HDIR) + (size_t)t * 1024 + 16 * lane; const float* h1 = h0 + (size_t)T * 1024;
    const bf16_t* o = (const bf16_t*)(p.ws + O_O) + (size_t)t * 1024 + 16 * lane; const float* gain = p.in[I_MNG] + l * 1024 + 16 * lane;
    float v[16];
    const u32x4 o0 = *(const u32x4*)o, o1 = *(const u32x4*)(o + 8);
#pragma unroll
    for (int q = 0; q < 4; ++q) { const f32x4 a = *(const f32x4*)(h0 + 4 * q), b = *(const f32x4*)(h1 + 4 * q);
#pragma unroll
        for (int e = 0; e < 4; ++e) v[4 * q + e] = a[e] + b[e]; }
#pragma unroll
    for (int q = 0; q < 4; ++q) { v[2 * q] *= sigmoidf_(bf_lo(o0[q])); v[2 * q + 1] *= sigmoidf_(bf_hi(o0[q])); v[8 + 2 * q] *= sigmoidf_(bf_lo(o1[q])); v[8 + 2 * q + 1] *= sigmoidf_(bf_hi(o1[q])); }
    float s = 0.f;
#pragma unroll
    for (int e = 0; e < 16; ++e) s += v[e];
    s += __shfl_xor(s, 1); s += __shfl_xor(s, 2); s += __shfl_xor(s, 4); s += __shfl_xor(s, 8);
    const float mu = s * (1.0f / 256.0f);
    float q2 = 0.f;
#pragma unroll
    for (int e = 0; e < 16; ++e) { v[e] -= mu; q2 += v[e] * v[e]; }
    q2 += __shfl_xor(q2, 1); q2 += __shfl_xor(q2, 2); q2 += __shfl_xor(q2, 4); q2 += __shfl_xor(q2, 8);
    const float rstd = rsqrtf(q2 * (1.0f / 256.0f) + LN_EPS);
    u32x4 w0, w1;
#pragma unroll
    for (int q = 0; q < 4; ++q) { w0[q] = pk_bf16(v[2 * q] * rstd * gain[2 * q], v[2 * q + 1] * rstd * gain[2 * q + 1]); w1[q] = pk_bf16(v[8 + 2 * q] * rstd * gain[8 + 2 * q], v[9 + 2 * q] * rstd * gain[9 + 2 * q]); }
    bf16_t* hn = (bf16_t*)(p.ws + O_HN) + (size_t)t * 1024 + 16 * lane;
    *(u32x4*)hn = w0; *(u32x4*)(hn + 8) = w1;
}

struct S5Coef { cf2 a; cf2 bbar[16]; };
DI void s5_coefs(const Params& p, int l, int dir, int g, int lane, S5Coef& c) {
    const size_t gi = ((size_t)l * 2 + dir) * 64 + g;
    const float step = expf(p.in[I_SLS][gi]);
    const float lr = p.in[I_SLR][gi * 64 + lane], lim = p.in[I_SLI][gi * 64 + lane];
    const float ar = lr * step, ai = lim * step;
    float sn, cs; sincosf(ai, &sn, &cs);
    const float ea = expf(ar);
    c.a = mk2(ea * cs, ea * sn);
    const float sh = sinf(0.5f * ai);
    const float nr = expm1f(ar) * cs - 2.0f * sh * sh, ni = ea * sn;
    const float inv = 1.0f / (lr * lr + lim * lim);
    const cf2 coef = mk2((nr * lr + ni * lim) * inv, (ni * lr - nr * lim) * inv);
    const float* br = p.in[I_SBR] + (gi * 64 + lane) * 16; const float* bi = p.in[I_SBI] + (gi * 64 + lane) * 16;
#pragma unroll
    for (int q = 0; q < 4; ++q) { const f32x4 r4 = *(const f32x4*)(br + 4 * q), i4 = *(const f32x4*)(bi + 4 * q);
#pragma unroll
        for (int e = 0; e < 4; ++e) c.bbar[4 * q + e] = cmul(coef, mk2(r4[e], i4[e])); }
}
DI void s5_prep_item(const Params& p, int item, LAS unsigned char* lds, int tid) {
    __syncthreads();
    const int l = item >> 6, g = item & 63;
    LAS cf2* Bb = (LAS cf2*)lds;
    LAS cf2* Cc = Bb + 2048;
    LAS cf2* Aa = Cc + 2048;
    LAS float* Kl = (LAS float*)(Aa + 128);
    if (tid < 128) { const int d = tid >> 6, pp = tid & 63; S5Coef cf; s5_coefs(p, l, d, g, pp, cf); Aa[tid] = cf.a;
#pragma unroll
        for (int m = 0; m < 16; ++m) Bb[tid * 16 + m] = cf.bbar[m]; }
#pragma unroll
    for (int i = 0; i < 4; ++i) { const int idx = tid + 512 * i, d = idx >> 10; const size_t gi = ((size_t)l * 2 + d) * 64 + g;
        Cc[idx] = mk2(p.in[I_SCR][gi * 1024 + (idx & 1023)], p.in[I_SCI][gi * 1024 + (idx & 1023)]); }
    __syncthreads();
    {
        const int d = tid >> 8, n = (tid >> 4) & 15, m = tid & 15;
        float Ka[16];
#pragma unroll
        for (int j = 0; j < 16; ++j) Ka[j] = 0.f;
        for (int pp = 0; pp < 64; ++pp) { cf2 z = cmul(Cc[(d * 16 + n) * 64 + pp], Bb[(d * 64 + pp) * 16 + m]); const cf2 a = Aa[d * 64 + pp];
#pragma unroll
            for (int j = 0; j < 16; ++j) { Ka[j] += z.x; z = cmul(z, a); } }
#pragma unroll
        for (int j = 0; j < 16; ++j) Kl[((d * 16 + j) * 16 + n) * 16 + m] = Ka[j];
    }
    __syncthreads();
    bf16_t* W = (bf16_t*)(p.ws + O_S5W) + ((size_t)l * 64 + g) * 256 * 512;
    bf16_t* E = (bf16_t*)(p.ws + O_S5E) + ((size_t)l * 64 + g) * 256 * 256;
    const float* skip = p.in[I_SSK] + l * 1024 + 16 * g;
#pragma unroll 1
    for (int i = 0; i < 64; ++i) { const int idx = tid + 512 * i, row = idx >> 7, k = (idx & 127) * 2, sr = row >> 4, n = row & 15, s2 = k >> 4, m = k & 15;
        float v0 = 0.f, v1 = 0.f;
        if (s2 <= sr) { v0 += Kl[((sr - s2) * 16 + n) * 16 + m]; v1 += Kl[((sr - s2) * 16 + n) * 16 + m + 1]; }
        if (s2 >= sr) { v0 += Kl[((16 + s2 - sr) * 16 + n) * 16 + m]; v1 += Kl[((16 + s2 - sr) * 16 + n) * 16 + m + 1]; }
        if (s2 == sr) { if (m == n) v0 += skip[n]; if (m + 1 == n) v1 += skip[n]; }
        *(unsigned*)(W + (size_t)row * 512 + k) = pk_bf16(v0, v1); }
#pragma unroll 1
    for (int i = 0; i < 4; ++i) { const int idx = tid + 512 * i, d = idx >> 10, n = (idx >> 6) & 15, pp = idx & 63;
        const cf2 a = Aa[d * 64 + pp]; cf2 z = cmul(Cc[(d * 16 + n) * 64 + pp], a);
#pragma unroll 1
        for (int e = 1; e <= 16; ++e) { const int sr = d == 0 ? e - 1 : 16 - e; bf16_t* w = W + (size_t)(sr * 16 + n) * 512 + 256 + d * 128 + pp;
            w[0] = (bf16_t)(pk_bf16(z.x, 0.f) & 0xffffu); w[64] = (bf16_t)(pk_bf16(-z.y, 0.f) & 0xffffu); z = cmul(z, a); } }
#pragma unroll 1
    for (int i = 0; i < 4; ++i) { const int idx = tid + 512 * i, d = idx >> 10, pp = (idx >> 4) & 63, m = idx & 15;
        const cf2 a = Aa[d * 64 + pp]; cf2 z = Bb[(d * 64 + pp) * 16 + m];
#pragma unroll 1
        for (int e = 0; e < 16; ++e) { const int s2 = d == 0 ? 15 - e : e; bf16_t* w = E + (size_t)(d * 128 + pp) * 256 + s2 * 16 + m;
            w[0] = (bf16_t)(pk_bf16(z.x, 0.f) & 0xffffu); w[(size_t)64 * 256] = (bf16_t)(pk_bf16(z.y, 0.f) & 0xffffu); z = cmul(z, a); } }
    __syncthreads();
}
template <int MODE>
DI void s5_mm(const Params& p, int l, int item, int tid) {
    constexpr int K = MODE ? 512 : 256;
    const int g = item >> 3, bt = item & 7, wid = __builtin_amdgcn_readfirstlane(tid >> 6), lane = tid & 63, fr = lane & 15, fq = lane >> 4;
    const int b0 = 64 * bt;
    const bf16_t* Ua = (const bf16_t*)(p.ws + O_SU) + ((size_t)g * 512 + b0 + fr) * 256 + 8 * fq;
    const bf16_t* Xa = (const bf16_t*)(p.ws + O_XIN) + ((size_t)g * 512 + b0 + fr) * 256 + 8 * fq;
    const bf16_t* Bw = (MODE ? (const bf16_t*)(p.ws + O_S5W) + ((size_t)l * 64 + g) * 256 * 512 : (const bf16_t*)(p.ws + O_S5E) + ((size_t)l * 64 + g) * 256 * 256) + (size_t)(32 * wid + fr) * K + 8 * fq;
    f32x4 acc[4][2];
#pragma unroll
    for (int r = 0; r < 4; ++r) { acc[r][0] = (f32x4){0.f, 0.f, 0.f, 0.f}; acc[r][1] = (f32x4){0.f, 0.f, 0.f, 0.f}; }
#pragma unroll 4
    for (int ks = 0; ks < K / 32; ++ks) {
        const bf16_t* ap = (ks < 8) ? Ua + 32 * ks : Xa + 32 * (ks - 8);
        const bf16x8 w0 = *(const bf16x8*)(Bw + 32 * ks), w1 = *(const bf16x8*)(Bw + (size_t)16 * K + 32 * ks);
#pragma unroll
        for (int r = 0; r < 4; ++r) { const bf16x8 af = *(const bf16x8*)(ap + (size_t)(16 * r) * 256);
            acc[r][0] = __builtin_amdgcn_mfma_f32_16x16x32_bf16(w0, af, acc[r][0], 0, 0, 0);
            acc[r][1] = __builtin_amdgcn_mfma_f32_16x16x32_bf16(w1, af, acc[r][1], 0, 0, 0); }
    }
    if (MODE == 0) {
#pragma unroll
        for (int r = 0; r < 4; ++r) { float* xe = (float*)(p.ws + O_XE) + ((size_t)g * 512 + b0 + 16 * r + fr) * 256 + 32 * wid + 4 * fq;
            *(f32x4*)xe = acc[r][0]; *(f32x4*)(xe + 16) = acc[r][1]; }
    } else {
#pragma unroll
        for (int r = 0; r < 4; ++r) { bf16_t* ys = (bf16_t*)(p.ws + O_YS) + (size_t)(16 * (b0 + 16 * r + fr) + 2 * wid) * 1024 + 16 * g + 4 * fq;
            *(u32x2*)ys = (u32x2){pk_bf16(acc[r][0][0], acc[r][0][1]), pk_bf16(acc[r][0][2], acc[r][0][3])};
            *(u32x2*)(ys + 1024) = (u32x2){pk_bf16(acc[r][1][0], acc[r][1][1]), pk_bf16(acc[r][1][2], acc[r][1][3])}; }
    }
}
DI void s5_scan(const Params& p, int l, int idx) {
    const int g = idx >> 7, d = (idx >> 6) & 1, pp = idx & 63;
    const size_t gi = ((size_t)l * 2 + d) * 64 + g;
    const float step = expf(p.in[I_SLS][gi]);
    const float ar = p.in[I_SLR][gi * 64 + pp] * step, ai = p.in[I_SLI][gi * 64 + pp] * step;
    float sn, cs; sincosf(ai, &sn, &cs); const float ea = expf(ar);
    cf2 a = mk2(ea * cs, ea * sn);
#pragma unroll
    for (int i = 0; i < 4; ++i) a = cmul(a, a);
    const float* __restrict__ xe = (const float*)(p.ws + O_XE) + (size_t)g * 512 * 256 + d * 128 + pp;
    bf16_t* __restrict__ xi = (bf16_t*)(p.ws + O_XIN) + (size_t)g * 512 * 256 + d * 128 + pp;
    cf2 X = mk2(0.f, 0.f);
#pragma unroll 1
    for (int i0 = 0; i0 < 512; i0 += 64) {
        float er[64], ei[64];
#pragma unroll
        for (int k = 0; k < 64; ++k) { const int b = d ? 511 - (i0 + k) : i0 + k; er[k] = xe[(size_t)b * 256]; ei[k] = xe[(size_t)b * 256 + 64]; }
#pragma unroll
        for (int k = 0; k < 64; ++k) { const int b = d ? 511 - (i0 + k) : i0 + k;
            xi[(size_t)b * 256] = (bf16_t)(pk_bf16(X.x, 0.f) & 0xffffu); xi[(size_t)b * 256 + 64] = (bf16_t)(pk_bf16(X.y, 0.f) & 0xffffu);
            X = cmul(a, X); X.x += er[k]; X.y += ei[k]; }
    }
}

template <int W>
DI void ln_store(float (&v)[32], const float* __restrict__ gam, const float* __restrict__ bet, float* dstf, bf16_t* dstb, int lane) {
    float s = 0.f;
#pragma unroll
    for (int i = 0; i < 32; ++i) s += v[i];
    const float mu = wave_sum(s) * (1.0f / 2048.0f);
    float q = 0.f;
#pragma unroll
    for (int i = 0; i < 32; ++i) { v[i] -= mu; q += v[i] * v[i]; }
    const float rstd = rsqrtf(wave_sum(q) * (1.0f / 2048.0f) + LN_EPS);
#pragma unroll
    for (int c = 0; c < 32 / W; ++c)
#pragma unroll
        for (int h = 0; h < W / 8; ++h) { const int o = 64 * W * c + W * lane + 8 * h, vi = W * c + 8 * h;
            const f32x4 g0 = *(const f32x4*)(gam + o), g1 = *(const f32x4*)(gam + o + 4), b0 = *(const f32x4*)(bet + o), b1 = *(const f32x4*)(bet + o + 4);
            f32x4 r0, r1;
#pragma unroll
            for (int e = 0; e < 4; ++e) { r0[e] = v[vi + e] * rstd * g0[e] + b0[e]; r1[e] = v[vi + 4 + e] * rstd * g1[e] + b1[e]; }
            *(f32x4*)(dstf + o) = r0; *(f32x4*)(dstf + o + 4) = r1;
            if (dstb) *(u32x4*)(dstb + o) = (u32x4){pk_bf16(r0[0], r0[1]), pk_bf16(r0[2], r0[3]), pk_bf16(r1[0], r1[1]), pk_bf16(r1[2], r1[3])}; }
}
template <int W>
DI void load_row32(const float* __restrict__ src, float (&v)[32], int lane) {
#pragma unroll
    for (int c = 0; c < 32 / W; ++c)
#pragma unroll
        for (int h = 0; h < W / 4; ++h) { const f32x4 a = *(const f32x4*)(src + 64 * W * c + W * lane + 4 * h);
#pragma unroll
            for (int e = 0; e < 4; ++e) v[W * c + 4 * h + e] = a[e]; }
}

constexpr int PB = 8;
DI void load_ln_row16(const float* __restrict__ src, const float* __restrict__ gam, const float* __restrict__ bet, float (&v)[32], int lane) {
    load_row32<16>(src, v, lane);
    float s = 0.f;
#pragma unroll
    for (int i = 0; i < 32; ++i) s += v[i];
    const float mu = wave_sum(s) * (1.0f / 2048.0f);
    float q = 0.f;
#pragma unroll
    for (int i = 0; i < 32; ++i) { v[i] -= mu; q += v[i] * v[i]; }
    const float rstd = rsqrtf(wave_sum(q) * (1.0f / 2048.0f) + LN_EPS);
#pragma unroll
    for (int c = 0; c < 2; ++c)
#pragma unroll
        for (int h = 0; h < 4; ++h) { const int o = 1024 * c + 16 * lane + 4 * h; const f32x4 g = *(const f32x4*)(gam + o), b = *(const f32x4*)(bet + o);
#pragma unroll
            for (int e = 0; e < 4; ++e) v[16 * c + 4 * h + e] = v[16 * c + 4 * h + e] * rstd * g[e] + b[e]; }
}
DI unsigned f2ord(float f) { const unsigned u = __float_as_uint(f); return (u & 0x80000000u) ? ~u : (u | 0x80000000u); }
DI float ord2f(unsigned k) { const unsigned u = (k & 0x80000000u) ? (k & 0x7fffffffu) : ~k; return __uint_as_float(u); }
#define INS16(L, key) do { unsigned k_ = (key); _Pragma("unroll") for (int q_ = 0; q_ < 16; ++q_) { const unsigned mx_ = max(L[q_], k_); k_ = min(L[q_], k_); L[q_] = mx_; } } while (0)
#define CE16(A, a, b) do { const unsigned hi_ = max(A[a], A[b]), lo_ = min(A[a], A[b]); A[a] = hi_; A[b] = lo_; } while (0);
#define SORT16_DESC(N) do { CE16(N,0,1) CE16(N,2,3) CE16(N,4,5) CE16(N,6,7) CE16(N,8,9) CE16(N,10,11) CE16(N,12,13) CE16(N,14,15) CE16(N,0,2) CE16(N,1,3) CE16(N,4,6) CE16(N,5,7) CE16(N,8,10) CE16(N,9,11) CE16(N,12,14) CE16(N,13,15) CE16(N,1,2) CE16(N,5,6) CE16(N,9,10) CE16(N,13,14) CE16(N,0,4) CE16(N,1,5) CE16(N,2,6) CE16(N,3,7) CE16(N,8,12) CE16(N,9,13) CE16(N,10,14) CE16(N,11,15) CE16(N,2,4) CE16(N,3,5) CE16(N,10,12) CE16(N,11,13) CE16(N,1,2) CE16(N,3,4) CE16(N,5,6) CE16(N,9,10) CE16(N,11,12) CE16(N,13,14) CE16(N,0,8) CE16(N,1,9) CE16(N,2,10) CE16(N,3,11) CE16(N,4,12) CE16(N,5,13) CE16(N,6,14) CE16(N,7,15) CE16(N,4,8) CE16(N,5,9) CE16(N,6,10) CE16(N,7,11) CE16(N,2,4) CE16(N,3,5) CE16(N,6,8) CE16(N,7,9) CE16(N,10,12) CE16(N,11,13) CE16(N,1,2) CE16(N,3,4) CE16(N,5,6) CE16(N,7,8) CE16(N,9,10) CE16(N,11,12) CE16(N,13,14) } while (0)
DI float gelu_tanh(float x) { const float z = 0.7978845608028654f * (x + 0.044715f * x * x * x); const float th = 1.0f - 2.0f / (__expf(2.0f * z) + 1.0f); return 0.5f * x * (1.0f + th); }
DI void peer_item(const Params& p, int l, int item, const float* __restrict__ gam, const float* __restrict__ bet, float* outf, bf16_t* outb, LAS unsigned char* lds, int tid_in) {
    __syncthreads();
    int tid = tid_in; asm volatile("" : "+v"(tid));
    const int t0 = item * 32, wid = __builtin_amdgcn_readfirstlane(tid >> 6), lane = tid & 63;
    LAS unsigned* TK = (LAS unsigned*)lds;
    LAS unsigned* EXI = TK + 32 * 16 * 16;
    LAS float* EXG = (LAS float*)(EXI + 32 * 128);
    LAS float* CO = EXG + 32 * 128 + wid * 128;
    {
        {
            const unsigned char* scb = p.ws + O_SCT + (size_t)t0 * 2;
            u32x4 ch[16];
#pragma unroll
            for (int i = 0; i < 16; ++i) { const int c = i * 512 + tid; ch[i] = *(const u32x4*)(scb + (size_t)(c >> 2) * (SCT_LD * 2) + (c & 3) * 16); }
#pragma unroll
            for (int i = 0; i < 16; ++i) { const int c = i * 512 + tid; *(LAS u32x4*)(lds + c * 16) = ch[i]; }
        }
        __syncthreads();
        const int tl = tid & 31, hc = tid >> 5;
        const LAS unsigned short* sc = (const LAS unsigned short*)lds + (hc * 128) * 32 + tl;
        unsigned L[16];
#pragma unroll
        for (int q = 0; q < 16; ++q) L[q] = 0u;
        unsigned R[16];
#pragma unroll
        for (int q = 0; q < 16; ++q) R[q] = (unsigned)sc[q * 32];
#pragma unroll 1
        for (int kb = 0; kb < 128; kb += 16) {
            unsigned N[16];
#pragma unroll
            for (int q = 0; q < 16; ++q) { const float v = __uint_as_float(R[q] << 16); N[q] = (f2ord(v) & ~127u) | (unsigned)(127 - kb - q); }
            if (kb < 112) {
#pragma unroll
                for (int q = 0; q < 16; ++q) R[q] = (unsigned)sc[(kb + 16 + q) * 32];
            }
            SORT16_DESC(N);
#pragma unroll
            for (int q = 0; q < 16; ++q) L[q] = max(L[q], N[15 - q]);
#pragma unroll
            for (int k = 8; k >= 1; k >>= 1)
#pragma unroll
                for (int q = 0; q < 16; ++q) if ((q & k) == 0) CE16(L, q, q + k);
        }
        __syncthreads();
#pragma unroll
        for (int q = 0; q < 16; ++q) TK[(tl * 16 + hc) * 16 + q] = L[q];
    }
    __syncthreads();
    if (tid < 256) {
        const int tl = tid & 31, h = tid >> 5;
        LAS unsigned* A = TK + (tl * 16 + 2 * h) * 16; LAS unsigned* B = A + 16;
        float fa[16], fb[16];
#pragma unroll
        for (int i = 0; i < 16; ++i) { fa[i] = ord2f(A[i] & ~127u); fb[i] = ord2f(B[i] & ~127u); }
        unsigned W[16];
#pragma unroll
        for (int q = 0; q < 16; ++q) W[q] = 0u;
#pragma unroll
        for (int i = 0; i < 16; ++i)
#pragma unroll
            for (int j = 0; j < 16; ++j) if ((i + 1) * (j + 1) <= 16) INS16(W, (f2ord(fa[i] + fb[j]) & ~255u) | (unsigned)(255 - (i * 16 + j)));
        const float vmax = ord2f(W[0] & ~255u);
        float ex[16], sum = 0.f;
#pragma unroll
        for (int r = 0; r < 16; ++r) { ex[r] = __expf(ord2f(W[r] & ~255u) - vmax); sum += ex[r]; }
        const float rs = 1.0f / sum;
#pragma unroll
        for (int r = 0; r < 16; ++r) { const unsigned c = 255u - (W[r] & 255u); const unsigned i1 = 127u - (A[c >> 4] & 127u), i2 = 127u - (B[c & 15u] & 127u);
            EXI[tl * 128 + h * 16 + r] = i1 * 128u + i2; EXG[tl * 128 + h * 16 + r] = ex[r] * rs; }
    }
    __syncthreads();
    const unsigned char* U8 = p.ws + O_U16; const unsigned char* V8 = p.ws + O_V16;
    const float* US = (const float*)(p.ws + O_U16 + (size_t)16384 * 2048); const float* VS = (const float*)(p.ws + O_V16 + (size_t)16384 * 2048);
#pragma unroll 1
    for (int ti = 0; ti < 4; ++ti) {
        const int tl = 4 * wid + ti, t = t0 + tl;
        int ln = lane; asm volatile("" : "+v"(ln));
        {
            const unsigned id0 = EXI[tl * 128 + ln], id1 = EXI[tl * 128 + 64 + ln]; const float g0 = EXG[tl * 128 + ln], g1 = EXG[tl * 128 + 64 + ln];
            int r0 = 0, r1 = 0;
#pragma unroll 8
            for (int j = 0; j < 128; ++j) { const unsigned o = EXI[tl * 128 + j];
                r0 += (o < id0 || (o == id0 && j < ln)) ? 1 : 0; r1 += (o < id1 || (o == id1 && j < ln + 64)) ? 1 : 0; }
            __builtin_amdgcn_wave_barrier();
            EXI[tl * 128 + r0] = id0; EXG[tl * 128 + r0] = g0; EXI[tl * 128 + r1] = id1; EXG[tl * 128 + r1] = g1;
            __builtin_amdgcn_wave_barrier();
        }
        {
            float xf[32]; load_ln_row16((const float*)(p.ws + O_Y1) + (size_t)t * DM, p.in[I_L1G] + l * DM, p.in[I_L1B] + l * DM, xf, ln);
            { LAS float* xn = EXG + 32 * 128 + 8 * 128 + wid * 2048;
#pragma unroll
              for (int c = 0; c < 2; ++c)
#pragma unroll
                  for (int h = 0; h < 4; ++h) *(LAS f32x4*)(xn + 1024 * c + 16 * ln + 4 * h) = (f32x4){xf[16 * c + 4 * h], xf[16 * c + 4 * h + 1], xf[16 * c + 4 * h + 2], xf[16 * c + 4 * h + 3]}; }
            f32x2 xp[16];
#pragma unroll
            for (int i = 0; i < 16; ++i) { xp[i].x = xf[2 * i]; xp[i].y = xf[2 * i + 1]; }
            const int eo = ((ln >> 5) & 1) * 4 + ((ln >> 4) & 1) * 2 + ((ln >> 3) & 1);
#pragma unroll 1
            for (int e0 = 0; e0 < 128; e0 += 8) {
                u32x4 ur[8][2];
#pragma unroll
                for (int k = 0; k < 8; ++k) { const unsigned id = EXI[tl * 128 + e0 + k]; const unsigned char* row = U8 + (size_t)id * 2048 + 16 * ln;
                    ur[k][0] = *(const u32x4*)row; ur[k][1] = *(const u32x4*)(row + 1024); }
                const unsigned ido = EXI[tl * 128 + e0 + eo]; const float sco = US[ido], gto = EXG[tl * 128 + e0 + eo];
                float d[8];
#pragma unroll
                for (int k = 0; k < 8; ++k) { f32x2 s2 = (f32x2){0.f, 0.f};
#pragma unroll
                    for (int c = 0; c < 2; ++c)
#pragma unroll
                        for (int e = 0; e < 4; ++e) { const f32x2 lo = __builtin_amdgcn_cvt_pk_f32_fp8(ur[k][c][e], false), hi = __builtin_amdgcn_cvt_pk_f32_fp8(ur[k][c][e], true);
                            s2 += lo * xp[8 * c + 2 * e]; s2 += hi * xp[8 * c + 2 * e + 1]; }
                    d[k] = s2.x + s2.y; }
                float q4[4], q2[2];
#pragma unroll
                for (int k = 0; k < 4; ++k) { const float snd = (ln & 32) ? d[k] : d[k + 4], kp = (ln & 32) ? d[k + 4] : d[k]; q4[k] = kp + __shfl_xor(snd, 32); }
#pragma unroll
                for (int k = 0; k < 2; ++k) { const float snd = (ln & 16) ? q4[k] : q4[k + 2], kp = (ln & 16) ? q4[k + 2] : q4[k]; q2[k] = kp + __shfl_xor(snd, 16); }
                float v = ((ln & 8) ? q2[1] : q2[0]) + __shfl_xor((ln & 8) ? q2[0] : q2[1], 8);
                v += __shfl_xor(v, 4); v += __shfl_xor(v, 2); v += __shfl_xor(v, 1);
                if ((ln & 7) == 0) CO[e0 + eo] = gelu_tanh(v * sco) * gto;
            }
        }
        __builtin_amdgcn_wave_barrier();
        float acc[32];
#pragma unroll
        for (int i = 0; i < 32; ++i) acc[i] = 0.f;
#pragma unroll 1
        for (int e0 = 0; e0 < 128; e0 += PB) {
            u32x4 vr[PB][2]; float cf[PB];
#pragma unroll
            for (int k = 0; k < PB; ++k) { const unsigned id = EXI[tl * 128 + e0 + k]; const unsigned char* row = V8 + (size_t)id * 2048 + 16 * ln;
                vr[k][0] = *(const u32x4*)row; vr[k][1] = *(const u32x4*)(row + 1024); cf[k] = VS[id] * CO[e0 + k]; }
#pragma unroll
            for (int k = 0; k < PB; ++k)
#pragma unroll
                for (int c = 0; c < 2; ++c)
#pragma unroll
                    for (int e = 0; e < 4; ++e) { const f32x2 lo = __builtin_amdgcn_cvt_pk_f32_fp8(vr[k][c][e], false), hi = __builtin_amdgcn_cvt_pk_f32_fp8(vr[k][c][e], true);
                        acc[16 * c + 4 * e] += cf[k] * lo.x; acc[16 * c + 4 * e + 1] += cf[k] * lo.y; acc[16 * c + 4 * e + 2] += cf[k] * hi.x; acc[16 * c + 4 * e + 3] += cf[k] * hi.y; }
        }
        {
            const LAS float* xn = EXG + 32 * 128 + 8 * 128 + wid * 2048;
#pragma unroll
            for (int c = 0; c < 2; ++c)
#pragma unroll
                for (int h = 0; h < 4; ++h) { const f32x4 xv = *(const LAS f32x4*)(xn + 1024 * c + 16 * ln + 4 * h);
#pragma unroll
                    for (int e = 0; e < 4; ++e) acc[16 * c + 4 * h + e] += ALPHA * xv[e]; }
        }
        ln_store<16>(acc, gam, bet, outf + (size_t)t * DM, outb ? outb + (size_t)t * DM : nullptr, ln);
        __builtin_amdgcn_wave_barrier();
    }
    __syncthreads();
}

DI void peer_row_fp8_cvt(float (&v)[32], unsigned char* __restrict__ dst, float* __restrict__ inv_scale, int row, int lane) {
    float m = 0.f;
#pragma unroll
    for (int i = 0; i < 32; ++i) m = fmaxf(m, fabsf(v[i]));
    m = wave_max(m);
    int ex = 0; if (m > 0.f) ex = (int)floorf(log2f(448.0f / m));
    ex = ex > 100 ? 100 : (ex < -100 ? -100 : ex);
    float sc = ldexpf(1.0f, ex); if (m * sc > 448.0f) { sc *= 0.5f; ex -= 1; }
#pragma unroll
    for (int c = 0; c < 2; ++c) { u32x4 w;
#pragma unroll
        for (int e = 0; e < 4; ++e) { unsigned x = 0u; x = __builtin_amdgcn_cvt_pk_fp8_f32(v[16 * c + 4 * e] * sc, v[16 * c + 4 * e + 1] * sc, x, false);
            x = __builtin_amdgcn_cvt_pk_fp8_f32(v[16 * c + 4 * e + 2] * sc, v[16 * c + 4 * e + 3] * sc, x, true); w[e] = x; }
        *(u32x4*)(dst + (size_t)row * 2048 + 1024 * c + 16 * lane) = w; }
    if (lane == 0) inv_scale[row] = ldexpf(1.0f, -ex);
}
DI void peer_rows_fp8(const float* __restrict__ src, unsigned char* __restrict__ dst, float* __restrict__ inv_scale, int row0, int lane) {
    float va[32], vb[32];
    load_row32<16>(src + (size_t)row0 * DM, va, lane); load_row32<16>(src + (size_t)(row0 + 1) * DM, vb, lane);
    peer_row_fp8_cvt(va, dst, inv_scale, row0, lane); peer_row_fp8_cvt(vb, dst, inv_scale, row0 + 1, lane);
}

template <int MASK>
DI void prologue_a(LAS unsigned char* lds, const int wid_s_) {
    {
        PHASE_ARGS(p, tid)
        if (MASK & 1) for (int it = bid; it < NL * TC_PER_LAYER; it += G) tconv_dispatch(p, it, (LAS float*)lds, tid);
        if (MASK & 1) for (int i = gtid; i < NL * 16 * 2048; i += gthreads) { const int l = i >> 15, j = (i >> 11) & 15, k = i & 2047; const float wv = p.in[I_WIN][((size_t)l * DM + k) * NIN + 4096 + j]; ((float*)(ws + O_WGT))[i] = wv; ((bf16_t*)(ws + O_WGB))[i] = (bf16_t)(pk_bf16(wv, 0.f) & 0xffffu); }
        if (MASK & 2) for (int it = bid; it < 1024; it += G) ws_item(p, it, tid);
        if (MASK & 4) for (int it = bid; it < NL * 64; it += G) s5_prep_item(p, it, lds, tid);
        if (MASK & 8) for (int it = gwave; it < NL * 8192; it += gwaves) hid2_item(p, it, lane);
        if (MASK & 8) for (int k = gtid; k < FN; k += gthreads) { float s, c; sincospif(-2.0f * (float)k / 16384.0f, &s, &c); ((cf2*)(ws + O_TW))[k] = mk2(c, s); }
        if (MASK & 8) for (int i = gtid; i < T * DM / 8; i += gthreads) { const f32x4 a = *(const f32x4*)(p.in[I_X] + (size_t)i * 8), b = *(const f32x4*)(p.in[I_X] + (size_t)i * 8 + 4);
            *(u32x4*)((bf16_t*)(ws + O_XB) + (size_t)i * 8) = (u32x4){pk_bf16(a[0], a[1]), pk_bf16(a[2], a[3]), pk_bf16(b[0], b[1]), pk_bf16(b[2], b[3])}; }
    }
}

template <int l>
DI void layer_body(LAS unsigned char* lds, const int wid_s_) {
#pragma unroll 1
        for (int rep_ = 0; rep_ < R_INP; ++rep_)
        {
        {
            PHASE_ARGS(p, tid)
            pg8::StaticOrder S1; S1.init(T, 10240, G, bid);
            pg8::gemm_phase(lds, pg8::Gemm{(const bf16_t*)(ws + O_XB), (const bf16_t*)(ws + O_WIN1) + (size_t)l * 10240 * 2048, T, 10240, 2048}, S1,
                            pg8::EpiIn1{(bf16_t*)(ws + O_Q), (bf16_t*)(ws + O_K), (bf16_t*)(ws + O_O), (bf16_t*)(ws + O_G), (bf16_t*)(ws + O_SU)}, tid);
        }
        {
            PHASE_ARGS(p, tid)
            pg8::StaticOrder S2; S2.init(4096, T, G, bid);
            pg8::gemm_phase(lds, pg8::Gemm{(const bf16_t*)(ws + O_WIN2) + (size_t)l * 4096 * 2048, (const bf16_t*)(ws + O_XB), 4096, T, 2048}, S2,
                            pg8::EpiIn2{(bf16_t*)(ws + O_VT), (bf16_t*)(ws + O_HPT)}, tid);
        }
        {
            PHASE_ARGS(p, tid)
            __syncthreads();
            LAS float* part = (LAS float*)lds;
            const int fr = lane & 15, fq = lane >> 4, tile = 2 * bid + (wid >> 2), kq = wid & 3;
            if (tile < T / 16) {
                const bf16_t* xa = (const bf16_t*)(ws + O_XB) + (size_t)(16 * tile + fr) * DM + 512 * kq + 8 * fq;
                const bf16_t* wb = (const bf16_t*)(ws + O_WGB) + ((size_t)l * 16 + fr) * 2048 + 512 * kq + 8 * fq;
                f32x4 acc = (f32x4){0.f, 0.f, 0.f, 0.f};
#pragma unroll
                for (int ks = 0; ks < 16; ++ks) acc = __builtin_amdgcn_mfma_f32_16x16x32_bf16(*(const bf16x8*)(xa + 32 * ks), *(const bf16x8*)(wb + 32 * ks), acc, 0, 0, 0);
#pragma unroll
                for (int j = 0; j < 4; ++j) part[(wid * 16 + 4 * fq + j) * 16 + fr] = acc[j];
            }
            __syncthreads();
            if (kq == 0 && tile < T / 16) {
#pragma unroll
                for (int j = 0; j < 4; ++j) { const int o = ((4 * fq + j) * 16 + fr); const int w0 = wid * 256;
                    ((float*)(ws + O_MG))[(size_t)(16 * tile + 4 * fq + j) * 16 + fr] = (part[w0 + o] + part[w0 + 256 + o]) + (part[w0 + 512 + o] + part[w0 + 768 + o]); }
            }
            __syncthreads();
        }
        }
        GRID_BARRIER();
#pragma unroll 1
        for (int rep_ = 0; rep_ < R_LOC; ++rep_)
        {
#pragma unroll 1
        for (int r2_ = 0; r2_ < R_LA; ++r2_)
        { PHASE_ARGS(p, tid) for (int it = bid; it < 512; it += G) mlstm_passA(p, l, it, lds, tid); }
#pragma unroll 1
        for (int r2_ = 0; r2_ < R_LH; ++r2_)
        { PHASE_ARGS(p, tid) for (int it = bid; it < 512; it += G) hyena_item(p, l, it, lds, tid); }
#pragma unroll 1
        for (int r2_ = 0; r2_ < R_LS; ++r2_)
        { PHASE_ARGS(p, tid) for (int it = bid; it < 512; it += G) s5_mm<0>(p, l, it, tid); }
        }
        GRID_BARRIER();
#pragma unroll 1
        for (int rep_ = 0; rep_ < R_SCAN; ++rep_)
        {
            PHASE_ARGS(p, tid)
            for (int it = bid; it < 2048; it += G) yh_transpose_item(p, it, lds, tid);
            mlstm_passB(p, gtid, gthreads, bid, tid);
            const float* pu = p.in[I_PU] + (size_t)l * 16384 * DM; const float* pv = p.in[I_PV] + (size_t)l * 16384 * DM;
            for (int bb = bid; bb < 256; bb += G) {
                if (wid == 0) { if (lane < 32) s5_scan(p, l, bb * 32 + lane); }
                else for (int r2 = bb * 64 + wid - 1; r2 < bb * 64 + 64; r2 += 7) {
                    if (r2 < 8192) peer_rows_fp8(pu, ws + O_U16, (float*)(ws + O_U16 + (size_t)16384 * 2048), 2 * r2, lane);
                    else peer_rows_fp8(pv, ws + O_V16, (float*)(ws + O_V16 + (size_t)16384 * 2048), 2 * (r2 - 8192), lane);
                }
            }
        }
        GRID_BARRIER();
#pragma unroll 1
        for (int rep_ = 0; rep_ < R_OUT; ++rep_)
        {
#pragma unroll 1
        for (int r2_ = 0; r2_ < R_OM; ++r2_)
        { PHASE_ARGS(p, tid) for (int it = bid; it < 512; it += G) mlstm_passC(p, l, it, lds, tid); }
#pragma unroll 1
        for (int r2_ = 0; r2_ < R_OS; ++r2_)
        { PHASE_ARGS(p, tid) for (int it = bid; it < 512; it += G) s5_mm<1>(p, l, it, tid); }
        }
        GRID_BARRIER();
#pragma unroll 1
        for (int rep_ = 0; rep_ < R_FIN; ++rep_)
        { PHASE_ARGS(p, tid) for (int t = gwave; t < T; t += gwaves) mlstm_final(p, l, t, lane); }
        GRID_BARRIER();
        {
            PHASE_ARGS(p, tid)
            pg8::BranchOrder Sb; Sb.base.init(T, 2048, G, bid);
            Sb.A0 = (const bf16_t*)(ws + O_HN); Sb.A1 = (const bf16_t*)(ws + O_YH); Sb.A2 = (const bf16_t*)(ws + O_YS);
            Sb.B0 = (const bf16_t*)(ws + O_WA) + (size_t)l * 2048 * 1024; Sb.B1 = (const bf16_t*)(ws + O_WB) + (size_t)l * 2048 * 1024; Sb.B2 = (const bf16_t*)(ws + O_WC) + (size_t)l * 4096 * 1024;
            pg8::gemm_phase(lds, pg8::Gemm{Sb.A0, Sb.B0, T, 2048, 1024}, Sb,
                            pg8::EpiBranchAll{(const bf16_t*)(ws + O_G), (bf16_t*)(ws + O_MRG), (bf16_t*)(ws + O_MRG) + (size_t)T * DM, (bf16_t*)(ws + O_MRGB)}, tid);
        }
        GRID_BARRIER();
#pragma unroll 1
        for (int rep_ = 0; rep_ < R_WOUT; ++rep_)
        {
            PHASE_ARGS(p, tid)
            const float* xcur = l == 0 ? p.in[I_X] : (const float*)(ws + O_XF);
            pg8::StaticOrder So; So.init(T, 2048, G, bid);
            pg8::gemm_phase(lds, pg8::Gemm{(const bf16_t*)(ws + O_MRGB), (const bf16_t*)(ws + O_WO) + (size_t)l * 2048 * 2048, T, 2048, 2048}, So, pg8::EpiWout{xcur, (float*)(ws + O_Y1), (bf16_t*)(ws + O_Y1B), (float*)(ws + O_STAT)}, tid);
        }
        GRID_BARRIER();
#pragma unroll 1
        for (int rep_ = 0; rep_ < R_SC; ++rep_)
        {
            PHASE_ARGS(p, tid)
            pg8::StaticOrder Ss; Ss.init(2048, T, G, bid);
            LAS float* MS = (LAS float*)(lds + 131072);
            { pg8::Unit u0; __syncthreads();
              if (Ss.next(0, u0) && tid < 256) { const float* st = (const float*)(ws + O_STAT) + (size_t)(u0.pn * 256 + tid) * 64; float s1 = 0.f, s2 = 0.f;
#pragma unroll
                  for (int i = 0; i < 16; ++i) { const f32x4 v = *(const f32x4*)(st + 4 * i); s1 += v[0] + v[2]; s2 += v[1] + v[3]; }
                  const float mu = s1 * (1.0f / 2048.0f), var = fmaxf(s2 * (1.0f / 2048.0f) - mu * mu, 0.f);
                  MS[2 * tid] = mu; MS[2 * tid + 1] = rsqrtf(var + LN_EPS); }
              __syncthreads(); }
            pg8::gemm_phase(lds, pg8::Gemm{(const bf16_t*)(ws + O_WS) + (size_t)l * 2048 * 2048, (const bf16_t*)(ws + O_Y1B), 2048, T, 2048}, Ss,
                            pg8::EpiScore{(bf16_t*)(ws + O_SCT), (const float*)(ws + O_C1) + l * 2048, (const float*)(ws + O_C2) + l * 2048, MS}, tid);
        }
        GRID_BARRIER();
#pragma unroll 1
        for (int rep_ = 0; rep_ < R_PEER; ++rep_)
        {
            PHASE_ARGS(p, tid)
            float* outf = l == NL - 1 ? p.out : (float*)(ws + O_XF); bf16_t* outb = l == NL - 1 ? nullptr : (bf16_t*)(ws + O_XB);
            for (int it = bid; it < T / 32; it += G) peer_item(p, l, it, p.in[I_L2G] + l * DM, p.in[I_L2B] + l * DM, outf, outb, lds, tid);
        }
        if (l < NL - 1) GRID_BARRIER();
    }

__global__ void __launch_bounds__(512, 2) mega(Params p_unused) {
    extern __shared__ __attribute__((aligned(16))) unsigned char smem[];
    LAS unsigned char* lds = (LAS unsigned char*)smem;
    const int wid_s_ = __builtin_amdgcn_readfirstlane((int)threadIdx.x >> 6);
    {
        volatile LAS unsigned* xbw = (volatile LAS unsigned*)(lds + LDS_BYTES - 16);
        if (threadIdx.x == 0) { xbw[0] = 0u; xbw[1] = 0u; xbw[2] = 0u; xbw[3] = 0u; }
        __syncthreads();
        PHASE_ARGS(p, tid) xcd_barrier_post((unsigned*)(p.ws + O_BAR));
    }

    prologue_a<15>(lds, wid_s_);
#ifdef PRO_DUP_MASK
    prologue_a<PRO_DUP_MASK>(lds, wid_s_);
#endif
    GRID_BARRIER();
    {
        PHASE_ARGS(p, tid)
        for (int it = bid; it < NL * 64; it += G) ftap_item(p, it, tid);
    }
    {
        PHASE_ARGS(p, tid)
        for (int i = gtid; i < NL * 2048; i += gthreads) {
            const float* a1 = (const float*)(ws + O_C1P) + (size_t)i * 128; const float* a2 = (const float*)(ws + O_C2P) + (size_t)i * 128; float s1 = 0.f, s2 = 0.f;
#pragma unroll 4
            for (int k = 0; k < 32; ++k) { const f32x4 u = *(const f32x4*)(a1 + 4 * k), v = *(const f32x4*)(a2 + 4 * k); s1 += (u[0] + u[1]) + (u[2] + u[3]); s2 += (v[0] + v[1]) + (v[2] + v[3]); }
            ((float*)(ws + O_C1))[i] = s1; ((float*)(ws + O_C2))[i] = s2; }
    }
    GRID_BARRIER();
#pragma unroll 1
    for (int rep_ = 0; rep_ < R_PROB; ++rep_)
    {
        PHASE_ARGS(p, tid)
        for (int it = bid; it < NL * 512; it += G) filt_item(p, it, lds, tid);
    }
    GRID_BARRIER();

    layer_body<0>(lds, wid_s_);
    layer_body<1>(lds, wid_s_);
    layer_body<2>(lds, wid_s_);
    layer_body<3>(lds, wid_s_);
}

extern "C" void kernel_launch(void* const* d_in, const int* in_sizes, int n_in, void* d_out, int out_size, void* d_ws, size_t ws_size, hipStream_t stream) {
    static int grid = 0;
    if (!grid) {
        int dev = 0, cus = 0, per_cu = 0;
        hipGetDevice(&dev);
        hipDeviceGetAttribute(&cus, hipDeviceAttributeMultiprocessorCount, dev);
        hipFuncSetAttribute((const void*)mega, hipFuncAttributeMaxDynamicSharedMemorySize, LDS_BYTES);
        hipOccupancyMaxActiveBlocksPerMultiprocessor(&per_cu, mega, NTHREADS, LDS_BYTES);
        if (per_cu < 1) { fprintf(stderr, "mega: occupancy query says 0 blocks per CU\n"); per_cu = 1; }
        grid = cus;
    }
    if (ws_size < WS_NEED || n_in < 34) { fprintf(stderr, "kernel_launch: workspace too small (%zu < %zu) or inputs missing\n", ws_size, (size_t)WS_NEED); return; }
    hipMemsetAsync((unsigned char*)d_ws + O_BAR, 0, 16384, stream);
    Params p{};
    for (int i = 0; i < 34; ++i) p.in[i] = (const float*)d_in[i];
    p.out = (float*)d_out; p.ws = (unsigned char*)d_ws;
    hipLaunchKernelGGL(mega, dim3(grid), dim3(NTHREADS), LDS_BYTES, stream, p);
}
```

```cpp
#include <hip/hip_runtime.h>
#include <stdint.h>
#include <stdio.h>

#define DI __device__ __forceinline__
#define LAS __attribute__((address_space(3)))
typedef unsigned short bf16_t;
typedef short bf16x8 __attribute__((ext_vector_type(8)));
typedef float f32x4 __attribute__((ext_vector_type(4)));
typedef float f32x2 __attribute__((ext_vector_type(2)));
typedef f32x2 cf2;
__device__ __forceinline__ cf2 mk2(float a, float b) { cf2 r; r.x = a; r.y = b; return r; }
typedef unsigned u32x4 __attribute__((ext_vector_type(4)));
typedef unsigned u32x2 __attribute__((ext_vector_type(2)));

constexpr int T = 8192, DM = 2048, BW = 1024, NL = 4, NIN = 14352;
constexpr float ALPHA = 1.6817928305074290f;
constexpr float LN_EPS = 1e-5f;
constexpr int NTHREADS = 512;
constexpr int LDS_BYTES = 153600;

constexpr size_t al256(size_t x) { return (x + 255) & ~(size_t)255; }
constexpr size_t O_BAR  = 0;
constexpr size_t O_TW   = 16384;
constexpr size_t O_WIN1 = O_TW + 131072;
constexpr size_t O_WIN2 = O_WIN1 + (size_t)NL * 10240 * 2048 * 2;
constexpr size_t O_WGT  = O_WIN2 + (size_t)NL * 4096 * 2048 * 2;
constexpr size_t O_WA   = O_WGT + (size_t)NL * 16 * 2048 * 4;
constexpr size_t O_WB   = O_WA + (size_t)NL * 2048 * 1024 * 2;
constexpr size_t O_WC   = O_WB + (size_t)NL * 2048 * 1024 * 2;
constexpr size_t O_WO   = O_WC + (size_t)NL * 4096 * 1024 * 2;
constexpr size_t O_WS   = O_WO + (size_t)NL * 2048 * 2048 * 2;
constexpr size_t O_U16  = O_WS + (size_t)NL * 2048 * 2048 * 2;
constexpr size_t O_V16  = O_U16 + (size_t)16384 * 2048 * 2;
constexpr size_t O_HID2 = O_V16 + (size_t)16384 * 2048 * 2;
constexpr int PM_STRIDE = 8200;
constexpr size_t O_PM   = O_HID2 + (size_t)NL * 8192 * 64 * 4;
constexpr size_t O_XB   = O_PM + (size_t)NL * 512 * PM_STRIDE * 16;
constexpr size_t O_XF   = O_XB + (size_t)T * DM * 2;
constexpr size_t O_Q    = O_XF + (size_t)T * DM * 4;
constexpr size_t O_FT   = O_Q;
constexpr size_t O_K    = O_Q + (size_t)T * 1024 * 2;
constexpr size_t O_O    = O_K + (size_t)T * 1024 * 2;
constexpr size_t O_SU   = O_O + (size_t)T * 1024 * 2;
constexpr size_t O_G    = O_SU + (size_t)T * 1024 * 4;
constexpr size_t O_KT   = O_G + (size_t)T * 6144 * 2;
constexpr size_t O_VT   = O_KT + (size_t)1024 * T * 2;
constexpr size_t O_HPT  = O_VT + (size_t)1024 * T * 2;
constexpr size_t O_SCT  = O_HPT;
constexpr int SCT_LD = T + 64;
constexpr size_t O_MG   = O_HPT + (size_t)3072 * T * 4;
constexpr size_t O_KV   = O_MG + (size_t)T * 16 * 4;
constexpr size_t O_MRG  = O_KV;
constexpr size_t O_YSD  = O_KV;
constexpr size_t O_Y1   = O_KV + (size_t)T * DM * 4;
constexpr size_t O_NLOC = O_KV + (size_t)512 * 65536 * 4;
constexpr size_t O_MLOC = O_NLOC + (size_t)512 * 256 * 4;
constexpr size_t O_BLAST= O_MLOC + 4096;
constexpr size_t O_CST  = O_BLAST + 4096;
constexpr size_t O_NST  = O_CST + (size_t)512 * 65536 * 2;
constexpr size_t O_MST  = O_NST + (size_t)512 * 256 * 4;
constexpr size_t O_HDIR = O_MST + 4096;
constexpr size_t O_HN   = O_HDIR + (size_t)2 * T * 1024 * 4;
constexpr size_t O_YH   = O_HN + (size_t)T * 1024 * 2;
constexpr size_t O_YS   = O_YH + (size_t)T * 1024 * 2;
constexpr size_t O_S5W  = O_YS + (size_t)T * 1024 * 2;
constexpr size_t O_S5E  = O_S5W + (size_t)NL * 64 * 256 * 512 * 2;
constexpr size_t O_XE   = O_S5E + (size_t)NL * 64 * 256 * 256 * 2;
constexpr size_t O_XIN  = O_XE + (size_t)64 * 512 * 256 * 4;
constexpr size_t O_MRGB = O_XIN + (size_t)64 * 512 * 256 * 2;
constexpr size_t O_X1F  = O_MRGB + (size_t)T * DM * 2;
constexpr size_t O_X1B  = O_X1F + (size_t)T * DM * 4;
constexpr size_t WS_NEED = O_X1B + (size_t)T * DM * 2;
constexpr size_t O_Y1B  = O_X1B;
constexpr size_t O_STAT = O_X1F;
constexpr size_t O_C1P  = O_X1F + ((size_t)4 << 20);
constexpr size_t O_C2P  = O_X1F + ((size_t)8 << 20);
constexpr size_t O_C1   = O_X1F + ((size_t)12 << 20);
constexpr size_t O_C2   = O_C1 + 65536;
constexpr size_t O_WGB  = O_X1F + ((size_t)13 << 20);
static_assert(WS_NEED < ((size_t)1 << 31), "workspace too large");
static_assert(O_MG - O_Q >= (size_t)NL * 2048 * 8192 * 4, "filter-tap alias does not fit");

#ifndef R_PROA
#define R_PROA 1
#endif
#ifndef R_PROB
#define R_PROB 1
#endif
#ifndef R_INP
#define R_INP 1
#endif
#ifndef R_LOC
#define R_LOC 1
#endif
#ifndef R_LA
#define R_LA 1
#endif
#ifndef R_LH
#define R_LH 1
#endif
#ifndef R_LS
#define R_LS 1
#endif
#ifndef R_OM
#define R_OM 1
#endif
#ifndef R_OS
#define R_OS 1
#endif
#ifndef R_SCAN
#define R_SCAN 1
#endif
#ifndef R_OUT
#define R_OUT 1
#endif
#ifndef R_FIN
#define R_FIN 1
#endif
#ifndef R_BR
#define R_BR 1
#endif
#ifndef R_WOUT
#define R_WOUT 1
#endif
#ifndef R_LN1
#define R_LN1 1
#endif
#ifndef R_SC
#define R_SC 1
#endif
#ifndef R_PEER
#define R_PEER 1
#endif
struct Params { const float* in[34]; float* out; unsigned char* ws; };
typedef const __attribute__((address_space(4))) Params* KParams;
#define PHASE_ARGS(q, tid) Params q; { KParams kp_ = (KParams)__builtin_amdgcn_kernarg_segment_ptr(); asm volatile("" : "+s"(kp_)); \
    _Pragma("unroll") for (int i_ = 0; i_ < 34; ++i_) q.in[i_] = kp_->in[i_]; q.out = kp_->out; q.ws = kp_->ws; } \
    int wid = wid_s_; asm volatile("" : "+s"(wid)); int lane; asm volatile("v_mbcnt_lo_u32_b32 %0, -1, 0\n\tv_mbcnt_hi_u32_b32 %0, -1, %0" : "=v"(lane)); const int tid = wid * 64 + lane; (void)wid; (void)lane; \
    const int bid = blockIdx.x, G = gridDim.x; const int gtid = bid * NTHREADS + tid, gthreads = G * NTHREADS, gwave = bid * 8 + wid, gwaves = G * 8; \
    (void)gtid; (void)gthreads; (void)gwave; (void)gwaves; unsigned char* ws = q.ws; (void)ws;
enum { I_X = 0, I_WIN, I_MGB, I_MNG, I_WMO, I_HCW, I_HCB, I_HW1, I_HB1, I_HW2, I_HB2, I_HFQ, I_HW3, I_HDC, I_HSK, I_WHO,
       I_SLR, I_SLI, I_SLS, I_SBR, I_SBI, I_SCR, I_SCI, I_SSK, I_WSG, I_WOUT, I_L1G, I_L1B, I_PWQ, I_PSK, I_PU, I_PV, I_L2G, I_L2B };

typedef __bf16 bf16x2v __attribute__((ext_vector_type(2)));
DI unsigned pk_bf16(float lo, float hi) { f32x2 v; v.x = lo; v.y = hi; return __builtin_bit_cast(unsigned, __builtin_convertvector(v, bf16x2v)); }
DI float bf_lo(unsigned w) { return __uint_as_float(w << 16); }
DI float bf_hi(unsigned w) { return __uint_as_float(w & 0xffff0000u); }
DI float sigmoidf_(float x) { return __builtin_amdgcn_rcpf(1.0f + __expf(-x)); }
DI float wave_sum(float v) { for (int o = 32; o > 0; o >>= 1) v += __shfl_xor(v, o); return v; }
DI float wave_max(float v) { for (int o = 32; o > 0; o >>= 1) v = fmaxf(v, __shfl_xor(v, o)); return v; }
DI float wave_scan_add(float v, int lane) { for (int o = 1; o < 64; o <<= 1) { float t = __shfl_up(v, o); if (lane >= o) v += t; } return v; }
DI float wave_scan_max(float v, int lane) { for (int o = 1; o < 64; o <<= 1) { float t = __shfl_up(v, o); if (lane >= o) v = fmaxf(v, t); } return v; }
DI cf2 cmul(cf2 a, cf2 b) { return mk2(a.x * b.x - a.y * b.y, a.x * b.y + a.y * b.x); }
DI cf2 cmulc(cf2 a, cf2 b) { return mk2(a.x * b.x + a.y * b.y, a.y * b.x - a.x * b.y); }

#define XB_TMO      128
#define XB_XCNT(j)  (256  + 64 * (j))
#define XB_XSUB(j)  (1280 + 64 * (j))
#define XB_XGEN(j)  (2304 + 64 * (j))
#define XB_TOP      3328
#define XB_TOPGEN   3392
#define XCD_BAR_WORDS 3456
#define XB_SPIN_CAP (1u << 22)
DI unsigned xb_ld(unsigned* p)              { return __hip_atomic_load(p, __ATOMIC_RELAXED, __HIP_MEMORY_SCOPE_AGENT); }
DI unsigned xb_add(unsigned* p, unsigned v) { return __hip_atomic_fetch_add(p, v, __ATOMIC_RELAXED, __HIP_MEMORY_SCOPE_AGENT); }
DI unsigned xb_xcc_id() { return (unsigned)__builtin_amdgcn_s_getreg((3 << 11) | 20) & 0xFu; }
#define XB_SPIN(cond, bar) do { unsigned _sp = 0; while (cond) { __builtin_amdgcn_s_sleep(1); \
    if ((++_sp & 255u) == 0u) { if (xb_ld(&(bar)[XB_TMO])) break; if (_sp > XB_SPIN_CAP) { atomicAdd(&(bar)[XB_TMO], 1u); break; } } } } while (0)
DI void xcd_barrier_complete(unsigned* bar, unsigned x, unsigned& nloc, unsigned& nx) {
    const unsigned G = gridDim.x * gridDim.y * gridDim.z;
    unsigned sum, cnt, mine, sp = 0u;
    for (;;) {
        sum = 0u; cnt = 0u; mine = 0u;
#pragma unroll
        for (unsigned j = 0; j < 16; ++j) { const unsigned c = xb_ld(&bar[XB_XCNT(j)]); sum += c; cnt += (c > 0u) ? 1u : 0u; mine = (j == x) ? c : mine; }
        if (sum == G) break;
        __builtin_amdgcn_s_sleep(1);
        if ((++sp & 255u) == 0u) { if (xb_ld(&bar[XB_TMO])) break; if (sp > XB_SPIN_CAP) { atomicAdd(&bar[XB_TMO], 1u); break; } }
    }
    nloc = mine > 0u ? mine : 1u; nx = cnt > 0u ? cnt : 1u;
}
DI void xcd_barrier_post(unsigned* bar) { if (threadIdx.x == 0) (void)xb_add(&bar[XB_XCNT(xb_xcc_id())], 1u); }
DI void xcd_barrier(unsigned* bar_in, volatile LAS unsigned* st, const bool is_t0) {
    asm volatile("s_waitcnt vmcnt(0)" ::: "memory");
    __syncthreads();
    if (is_t0) {
        unsigned* bar = bar_in; asm volatile("" : "+s"(bar));
        const unsigned x = xb_xcc_id();
        __builtin_amdgcn_s_waitcnt(0);
        unsigned nloc = st[0], nx = st[1];
        if (nloc == 0u) { xcd_barrier_complete(bar, x, nloc, nx); st[0] = nloc; st[1] = nx; }
        const unsigned old = xb_add(&bar[XB_XSUB(x)], 1u);
        const unsigned gen = old / nloc;
        if (old + 1u == (gen + 1u) * nloc) {
            __builtin_amdgcn_fence(__ATOMIC_RELEASE, "agent");
            asm volatile("s_waitcnt vmcnt(0)" ::: "memory");
            const unsigned og = xb_add(&bar[XB_TOP], 1u);
            const unsigned tg = og / nx;
            if (og + 1u == (tg + 1u) * nx) xb_add(&bar[XB_TOPGEN], 1u);
            else XB_SPIN(xb_ld(&bar[XB_TOPGEN]) == tg, bar);
            __builtin_amdgcn_fence(__ATOMIC_ACQUIRE, "agent");
            xb_add(&bar[XB_XGEN(x)], 1u);
            asm volatile("s_waitcnt vmcnt(0)" ::: "memory");
        } else {
            XB_SPIN(xb_ld(&bar[XB_XGEN(x)]) == gen, bar);
            __builtin_amdgcn_fence(__ATOMIC_ACQUIRE, "agent");
            asm volatile("s_waitcnt vmcnt(0)" ::: "memory");
        }
    }
    __syncthreads();
}
#define GRID_BARRIER() do { KParams kb_ = (KParams)__builtin_amdgcn_kernarg_segment_ptr(); asm volatile("" : "+s"(kb_)); \
    xcd_barrier((unsigned*)(kb_->ws + O_BAR), (volatile LAS unsigned*)(lds + LDS_BYTES - 16), wid_s_ == 0 && __builtin_amdgcn_mbcnt_hi(~0u, __builtin_amdgcn_mbcnt_lo(~0u, 0u)) == 0u); } while (0)

namespace pg8 {
constexpr int BM = 256, BK = 64, HALF = 128, HTB = HALF * BK * 2, STAGE_BYTES = 8 * HTB, NXCD = 8, WGM = 8;
DI int lds_byte(int r, int c) { const int st = (r >> 4) * 2 + (c >> 5), rr = r & 15, cc = c & 31, ob = rr * 64 + cc * 2; return st * 1024 + (ob ^ (((ob >> 9) & 1) << 5)); }
DI void stage_rc(int b, int& R, int& C) { const int st = b / 1024, sb = b % 1024, swz = sb ^ (((sb >> 9) & 1) << 5); R = (st >> 1) * 16 + swz / 64; C = (st & 1) * 32 + (swz % 64) / 2; }
DI int perm32(int rho) { const int n = rho >> 4, i = rho & 15; return 8 * (i >> 2) + 4 * n + (i & 3); }
struct Unit { int pm, pn, which; };
struct Gemm { const bf16_t* A; const bf16_t* Bt; int M, N, K; };
struct StaticOrder {
    int nM, nN, nwg, G, c;
    DI void init(int M, int N, int G_, int c_) { nM = M / BM; nN = N / BM; nwg = nM * nN; G = G_; c = c_; }
    DI bool next(int i, Unit& u) const {
        const long L = (long)i * G + c; if (L >= nwg) return false;
        int wgid = (int)L; { const int q = nwg / NXCD, r = nwg % NXCD, xcd = wgid % NXCD, off = wgid / NXCD; wgid = (xcd < r ? xcd * (q + 1) : r * (q + 1) + (xcd - r) * q) + off; }
        const int nig = WGM * nN, gid = wgid / nig, fm = gid * WGM, gsz = (nM - fm) < WGM ? (nM - fm) : WGM;
        u.pm = fm + ((wgid % nig) % gsz); u.pn = (wgid % nig) / gsz; u.which = 0; return true;
    }
    DI void a_ready(const Unit&) const {}
    DI void done(const Unit&) const {}
    DI const char* a_base(const Gemm& g, const Unit& u, size_t tstep) const { return (const char*)g.A + (size_t)u.pm * tstep; }
    DI const char* b_base(const Gemm& g, const Unit& u, size_t tstep) const { return (const char*)g.Bt + (size_t)u.pn * tstep; }
};
struct BranchOrder {
    StaticOrder base; const bf16_t *A0, *A1, *A2, *B0, *B1, *B2;
    DI bool next(int i, Unit& u) const { Unit b; if (i > 3 || !base.next(0, b)) return false; u.pm = b.pm; u.which = i; u.pn = i < 2 ? b.pn : 2 * b.pn + (i - 2); return true; }
    DI void a_ready(const Unit&) const {}
    DI void done(const Unit&) const {}
    DI const char* a_base(const Gemm&, const Unit& u, size_t tstep) const { const bf16_t *a0 = A0, *a1 = A1, *a2 = A2; asm volatile("" : "+s"(a0), "+s"(a1), "+s"(a2));
        return (const char*)(u.which == 0 ? a0 : (u.which == 1 ? a1 : a2)) + (size_t)u.pm * tstep; }
    DI const char* b_base(const Gemm&, const Unit& u, size_t tstep) const { const bf16_t *b0 = B0, *b1 = B1, *b2 = B2; asm volatile("" : "+s"(b0), "+s"(b1), "+s"(b2));
        return (const char*)(u.which == 0 ? b0 : (u.which == 1 ? b1 : b2)) + (size_t)u.pn * tstep; }
};

template <class Epi, class Sched>
DI void gemm_phase(LAS unsigned char* lds, const Gemm g, const Sched& S, const Epi& E, const int tid) {
    const int wid = __builtin_amdgcn_readfirstlane(tid >> 6), lane = tid & 63, wr = wid >> 2, wc = wid & 3, fr = lane & 15, fq = lane >> 4;
    const int K = g.K, nt = K / BK;
    unsigned voffA[2], voffB[2];
#pragma unroll
    for (int i = 0; i < 2; ++i) { int R, C; stage_rc(tid * 16 + i * 8192, R, C); const int Rb = Epi::PERM ? ((R & ~31) + perm32(R & 31)) : R;
        voffA[i] = (unsigned)(R * K + C) * 2u; voffB[i] = (unsigned)(Rb * K + C) * 2u; }
    const size_t kstep = (size_t)(BK * 2);
    const size_t hstep = (size_t)HALF * K * 2;
    const size_t tstep = 2 * hstep;
    const unsigned ldsw = (unsigned)wid * 1024u;
    const int aoff = lds_byte(wr * 64 + fr, fq * 8), boff = lds_byte(wc * 32 + fr, fq * 8);
#define PG8_SA(b, h) (((b) * 2 + (h)) * HTB)
#define PG8_SB(b, h) ((4 + (b) * 2 + (h)) * HTB)
#define PG8_STAGE(bufoff, gbase, voff) do { _Pragma("unroll") for (int _i = 0; _i < 2; ++_i) \
        __builtin_amdgcn_global_load_lds((const unsigned*)((const char*)(gbase) + (voff)[_i]), (LAS unsigned*)(lds + (bufoff) + ldsw + _i * 8192), 16, 0, 0); } while (0)
#define PG8_LDA(dst, b, h) do { _Pragma("unroll") for (int m = 0; m < 4; ++m) _Pragma("unroll") for (int k = 0; k < 2; ++k) dst[m][k] = *(const LAS bf16x8*)(lds + PG8_SA(b, h) + aoff + m * 2048 + k * 1024); } while (0)
#define PG8_LDB(dst, b, h) do { _Pragma("unroll") for (int n = 0; n < 2; ++n) _Pragma("unroll") for (int k = 0; k < 2; ++k) dst[n][k] = *(const LAS bf16x8*)(lds + PG8_SB(b, h) + boff + n * 2048 + k * 1024); } while (0)
#define PG8_MMA(ai, bj, At, Bt) do { __builtin_amdgcn_s_setprio(1); _Pragma("unroll") for (int m = 0; m < 4; ++m) _Pragma("unroll") for (int n = 0; n < 2; ++n) _Pragma("unroll") for (int k = 0; k < 2; ++k) \
        acc[ai][bj][m][n] = __builtin_amdgcn_mfma_f32_16x16x32_bf16(Bt[n][k], At[m][k], acc[ai][bj][m][n], 0, 0, 0); __builtin_amdgcn_s_setprio(0); } while (0)
#define PG8_WAIT_V(n) asm volatile("s_waitcnt vmcnt(" #n ")" ::: "memory")
#define PG8_WAIT_L(n) asm volatile("s_waitcnt lgkmcnt(" #n ")" ::: "memory")
#define PG8_BAR __builtin_amdgcn_s_barrier()
#define PG8_SCHED __builtin_amdgcn_sched_barrier(0)
    Unit cur, nxt; int ui = 0;
    if (!S.next(0, cur)) return;
    f32x4 acc[2][2][4][2];
#pragma unroll
    for (int a = 0; a < 2; ++a)
#pragma unroll
        for (int b = 0; b < 2; ++b)
#pragma unroll
            for (int m = 0; m < 4; ++m)
#pragma unroll
                for (int n = 0; n < 2; ++n) acc[a][b][m][n] = (f32x4){0.f, 0.f, 0.f, 0.f};
    bf16x8 At[4][2], B0[2][2], B1[2][2];
    const char* cA = S.a_base(g, cur, tstep); const char* cB = S.b_base(g, cur, tstep);
    S.a_ready(cur);
    PG8_STAGE(PG8_SB(0, 0), cB, voffB); PG8_STAGE(PG8_SA(0, 0), cA, voffA); PG8_STAGE(PG8_SB(0, 1), cB + hstep, voffB); PG8_STAGE(PG8_SA(0, 1), cA + hstep, voffA);
    if (wr == 1) PG8_BAR;
    PG8_WAIT_V(4); PG8_BAR;
    PG8_STAGE(PG8_SB(1, 0), cB + kstep, voffB); PG8_STAGE(PG8_SA(1, 0), cA + kstep, voffA); PG8_STAGE(PG8_SB(1, 1), cB + hstep + kstep, voffB);
    PG8_WAIT_V(6); PG8_BAR;
    for (;;) {
        const bool has_next = S.next(ui + 1, nxt);
        const char* nA = has_next ? S.a_base(g, nxt, tstep) : cA; const char* nB = has_next ? S.b_base(g, nxt, tstep) : cB;
        for (int t = 0; t < nt; t += 2) {
            const bool last = (t == nt - 2);
            const char* a1 = cA + (size_t)(t + 1) * kstep;
            const char* a2 = last ? nA : cA + (size_t)(t + 2) * kstep; const char* b2 = last ? nB : cB + (size_t)(t + 2) * kstep;
            const char* a3 = a2 + kstep; const char* b3 = b2 + kstep;
            if (last && has_next) S.a_ready(nxt);
            PG8_LDB(B0, 0, 0); PG8_SCHED; PG8_LDA(At, 0, 0); PG8_STAGE(PG8_SA(1, 1), a1 + hstep, voffA);
            PG8_WAIT_L(8); PG8_BAR; PG8_WAIT_L(0); PG8_MMA(0, 0, At, B0); PG8_BAR; PG8_SCHED;
            PG8_LDB(B1, 0, 1); PG8_STAGE(PG8_SB(0, 0), b2, voffB);
            PG8_BAR; PG8_WAIT_L(0); PG8_MMA(0, 1, At, B1); PG8_BAR;
            PG8_LDA(At, 0, 1); PG8_STAGE(PG8_SA(0, 0), a2, voffA);
            PG8_BAR; PG8_WAIT_L(0); PG8_MMA(1, 0, At, B0); PG8_BAR; PG8_SCHED;
            PG8_STAGE(PG8_SB(0, 1), b2 + hstep, voffB);
            PG8_WAIT_V(6); PG8_BAR; PG8_MMA(1, 1, At, B1); PG8_BAR;
            PG8_LDB(B0, 1, 0); PG8_SCHED; PG8_LDA(At, 1, 0); PG8_STAGE(PG8_SA(0, 1), a2 + hstep, voffA);
            PG8_WAIT_L(8); PG8_BAR; PG8_WAIT_L(0); PG8_MMA(0, 0, At, B0); PG8_BAR; PG8_SCHED;
            PG8_LDB(B1, 1, 1); PG8_STAGE(PG8_SB(1, 0), b3, voffB);
            PG8_BAR; PG8_WAIT_L(0); PG8_MMA(0, 1, At, B1); PG8_BAR;
            PG8_LDA(At, 1, 1); PG8_STAGE(PG8_SA(1, 0), a3, voffA);
            PG8_BAR; PG8_WAIT_L(0); PG8_MMA(1, 0, At, B0); PG8_BAR; PG8_SCHED;
            PG8_STAGE(PG8_SB(1, 1), b3 + hstep, voffB);
            PG8_WAIT_V(6); PG8_BAR; PG8_MMA(1, 1, At, B1); PG8_BAR;
        }
        E(acc, cur, wr, wc, fr, fq);
        if (!has_next) break;
#pragma unroll
        for (int a = 0; a < 2; ++a)
#pragma unroll
            for (int b = 0; b < 2; ++b)
#pragma unroll
                for (int m = 0; m < 4; ++m)
#pragma unroll
                    for (int n = 0; n < 2; ++n) acc[a][b][m][n] = (f32x4){0.f, 0.f, 0.f, 0.f};
        cur = nxt; cA = nA; cB = nB; ++ui;
    }
    PG8_WAIT_V(0);
    if (wr == 0) PG8_BAR;
    PG8_BAR;
#undef PG8_SA
#undef PG8_SB
#undef PG8_STAGE
#undef PG8_LDA
#undef PG8_LDB
#undef PG8_MMA
#undef PG8_WAIT_V
#undef PG8_WAIT_L
#undef PG8_BAR
#undef PG8_SCHED
}

DI u32x4 pack8(const f32x4& a, const f32x4& b) { return (u32x4){pk_bf16(a[0], a[1]), pk_bf16(a[2], a[3]), pk_bf16(b[0], b[1]), pk_bf16(b[2], b[3])}; }
DI f32x4 sig4(const f32x4& a) { return (f32x4){sigmoidf_(a[0]), sigmoidf_(a[1]), sigmoidf_(a[2]), sigmoidf_(a[3])}; }

struct EpiIn1 {
    static constexpr bool PERM = true;
    bf16_t *Q, *K, *O, *G, *SUG;
    DI void operator()(const f32x4 (&acc)[2][2][4][2], const Unit& u, int wr, int wc, int fr, int fq) const {
        const int row0 = u.pm * BM + wr * 64 + fr, colt = u.pn * BM + wc * 32 + 8 * fq;
#pragma unroll
        for (int ai = 0; ai < 2; ++ai)
#pragma unroll
            for (int m = 0; m < 4; ++m) { const size_t row = (size_t)(row0 + ai * HALF + m * 16);
#pragma unroll
                for (int bj = 0; bj < 2; ++bj) { const int c = colt + bj * HALF; const f32x4 v0 = acc[ai][bj][m][0], v1 = acc[ai][bj][m][1];
                    if (u.pn < 4)       *(u32x4*)(Q + row * 1024 + c) = pack8(v0, v1);
                    else if (u.pn < 8)  *(u32x4*)(K + row * 1024 + (c - 1024)) = pack8(v0 * 0.0625f, v1 * 0.0625f);
                    else if (u.pn < 12) *(u32x4*)(O + row * 1024 + (c - 2048)) = pack8(v0, v1);
                    else if (u.pn < 16) { const int ch = c - 3072; *(u32x4*)(SUG + ((size_t)(ch >> 4) * T + row) * 16 + (ch & 15)) = pack8(v0, v1); }
                    else                *(u32x4*)(G + row * 6144 + (c - 4096)) = pack8(sig4(v0), sig4(v1));
                } }
    }
};
struct EpiIn2 {
    static constexpr bool PERM = true;
    bf16_t *VT, *HPT;
    DI void operator()(const f32x4 (&acc)[2][2][4][2], const Unit& u, int wr, int wc, int fr, int fq) const {
        const int row0 = u.pm * BM + wr * 64 + fr, colt = u.pn * BM + wc * 32 + 8 * fq;
#pragma unroll
        for (int ai = 0; ai < 2; ++ai)
#pragma unroll
            for (int m = 0; m < 4; ++m) { const int row = row0 + ai * HALF + m * 16;
#pragma unroll
                for (int bj = 0; bj < 2; ++bj) { const int c = colt + bj * HALF; const f32x4 v0 = acc[ai][bj][m][0], v1 = acc[ai][bj][m][1];
                    if (u.pm < 4) *(u32x4*)(VT + (size_t)row * T + c) = pack8(v0, v1);
                    else *(u32x4*)(HPT + (size_t)(row - 1024) * T + c) = pack8(v0, v1);
                } }
    }
};
struct EpiBranchAll {
    static constexpr bool PERM = true;
    const bf16_t* G; bf16_t *T1, *T2, *MRGB;
    DI void operator()(const f32x4 (&acc)[2][2][4][2], const Unit& u, int wr, int wc, int fr, int fq) const {
        const int row0 = u.pm * BM + wr * 64 + fr;
        if (u.which < 2) {
            const int colt = u.pn * BM + wc * 32 + 8 * fq; bf16_t* Td = u.which ? T2 : T1;
#pragma unroll
            for (int ai = 0; ai < 2; ++ai)
#pragma unroll
                for (int m = 0; m < 4; ++m) { const size_t row = (size_t)(row0 + ai * HALF + m * 16);
#pragma unroll
                    for (int bj = 0; bj < 2; ++bj) { const int c = colt + bj * HALF;
                        const u32x4 gw = *(const u32x4*)(G + row * 6144 + u.which * 2048 + c);
                        const f32x4 g0 = (f32x4){bf_lo(gw[0]), bf_hi(gw[0]), bf_lo(gw[1]), bf_hi(gw[1])}, g1 = (f32x4){bf_lo(gw[2]), bf_hi(gw[2]), bf_lo(gw[3]), bf_hi(gw[3])};
                        *(u32x4*)(Td + row * DM + c) = pack8(g0 * acc[ai][bj][m][0], g1 * acc[ai][bj][m][1]); } }
        } else {
            const int c = u.pn * HALF + wc * 32 + 8 * fq;
#pragma unroll
            for (int ai = 0; ai < 2; ++ai)
#pragma unroll
                for (int m = 0; m < 4; ++m) { const size_t row = (size_t)(row0 + ai * HALF + m * 16);
                    const u32x4 gw = *(const u32x4*)(G + row * 6144 + 2 * 2048 + c), t1 = *(const u32x4*)(T1 + row * DM + c), t2 = *(const u32x4*)(T2 + row * DM + c);
                    const f32x4 g0 = (f32x4){bf_lo(gw[0]), bf_hi(gw[0]), bf_lo(gw[1]), bf_hi(gw[1])}, g1 = (f32x4){bf_lo(gw[2]), bf_hi(gw[2]), bf_lo(gw[3]), bf_hi(gw[3])};
                    const f32x4 s0 = (f32x4){bf_lo(t1[0]) + bf_lo(t2[0]), bf_hi(t1[0]) + bf_hi(t2[0]), bf_lo(t1[1]) + bf_lo(t2[1]), bf_hi(t1[1]) + bf_hi(t2[1])};
                    const f32x4 s1 = (f32x4){bf_lo(t1[2]) + bf_lo(t2[2]), bf_hi(t1[2]) + bf_hi(t2[2]), bf_lo(t1[3]) + bf_lo(t2[3]), bf_hi(t1[3]) + bf_hi(t2[3])};
                    *(u32x4*)(MRGB + row * DM + c) = pack8(s0 + g0 * acc[ai][0][m][0] * sig4(acc[ai][1][m][0]), s1 + g1 * acc[ai][0][m][1] * sig4(acc[ai][1][m][1]));
                }
        }
    }
};
struct EpiWout {
    static constexpr bool PERM = true;
    const float* X; float* Y1; bf16_t* Y1B; float* STAT;
    DI void operator()(const f32x4 (&acc)[2][2][4][2], const Unit& u, int wr, int wc, int fr, int fq) const {
        const int row0 = u.pm * BM + wr * 64 + fr, colt = u.pn * BM + wc * 32 + 8 * fq;
#pragma unroll
        for (int ai = 0; ai < 2; ++ai)
#pragma unroll
            for (int m = 0; m < 4; ++m) { const size_t row = (size_t)(row0 + ai * HALF + m * 16);
                float s1 = 0.f, s2 = 0.f;
#pragma unroll
                for (int bj = 0; bj < 2; ++bj) { const size_t o = row * DM + colt + bj * HALF;
                    const f32x4 y0 = ALPHA * *(const f32x4*)(X + o) + acc[ai][bj][m][0], y1 = ALPHA * *(const f32x4*)(X + o + 4) + acc[ai][bj][m][1];
                    *(f32x4*)(Y1 + o) = y0; *(f32x4*)(Y1 + o + 4) = y1; *(u32x4*)(Y1B + o) = pack8(y0, y1);
#pragma unroll
                    for (int e = 0; e < 4; ++e) { s1 += y0[e] + y1[e]; s2 += y0[e] * y0[e] + y1[e] * y1[e]; } }
                s1 += __shfl_xor(s1, 16); s1 += __shfl_xor(s1, 32); s2 += __shfl_xor(s2, 16); s2 += __shfl_xor(s2, 32);
                if (fq == 0) *(f32x2*)(STAT + (row * 32 + u.pn * 4 + wc) * 2) = (f32x2){s1, s2};
            }
    }
};
struct EpiScore {
    static constexpr bool PERM = true;
    bf16_t* C; const float *C1, *C2; const LAS float* MS;
    DI void operator()(const f32x4 (&acc)[2][2][4][2], const Unit& u, int wr, int wc, int fr, int fq) const {
        const int row0 = u.pm * BM + wr * 64 + fr, tl0 = wc * 32 + 8 * fq, colt = u.pn * BM + tl0;
        f32x4 mu[2][2], rs[2][2];
#pragma unroll
        for (int bj = 0; bj < 2; ++bj)
#pragma unroll
            for (int n = 0; n < 2; ++n)
#pragma unroll
                for (int e = 0; e < 4; ++e) { const int tl = tl0 + bj * HALF + 4 * n + e; mu[bj][n][e] = MS[2 * tl]; rs[bj][n][e] = MS[2 * tl + 1]; }
#pragma unroll
        for (int ai = 0; ai < 2; ++ai)
#pragma unroll
            for (int m = 0; m < 4; ++m) { const size_t row = (size_t)(row0 + ai * HALF + m * 16); const float c1 = C1[row], c2 = C2[row];
#pragma unroll
                for (int bj = 0; bj < 2; ++bj) { bf16_t* d = C + row * SCT_LD + colt + bj * HALF;
                    *(u32x4*)d = pack8(rs[bj][0] * (acc[ai][bj][m][0] - mu[bj][0] * c1) + c2, rs[bj][1] * (acc[ai][bj][m][1] - mu[bj][1] * c1) + c2); } }
    }
};
}

DI void tconv_item(const float* __restrict__ src, size_t ld, int c0, bf16_t* __restrict__ dst, int K, int k0, LAS float* tile, int tid) {
    __syncthreads();
    { float v[32]; const float* sp = src + (size_t)(k0 + (tid >> 6)) * ld + c0 + (tid & 63);
#pragma unroll
      for (int i = 0; i < 32; ++i) v[i] = sp[(size_t)(8 * i) * ld];
#pragma unroll
      for (int i = 0; i < 32; ++i) tile[((tid >> 6) + 8 * i) * 65 + (tid & 63)] = v[i]; }
    __syncthreads();
#pragma unroll
    for (int i = 0; i < 4; ++i) { const int idx = tid + 512 * i, rr = idx >> 5, ks = idx & 31;
        float v[8];
#pragma unroll
        for (int j = 0; j < 8; ++j) v[j] = tile[(ks * 8 + j) * 65 + rr];
        *(u32x4*)(dst + (size_t)rr * K + k0 + ks * 8) = (u32x4){pk_bf16(v[0], v[1]), pk_bf16(v[2], v[3]), pk_bf16(v[4], v[5]), pk_bf16(v[6], v[7])}; }
    __syncthreads();
}
constexpr int TC_PER_LAYER = 2560;
DI void tconv_dispatch(const Params& p, int item, LAS float* tile, int tid) {
    const int l = item / TC_PER_LAYER; int it = item % TC_PER_LAYER;
    unsigned char* ws = p.ws;
    if (it < 1792) {
        const int rt = it >> 3, kt = it & 7; int r0 = rt * 64; const float* src = p.in[I_WIN] + (size_t)l * DM * NIN;
        if (rt < 160) { const int col = r0 < 2048 ? r0 : (r0 < 3072 ? r0 + 1024 : r0 + 4112);
            tconv_item(src, NIN, col, (bf16_t*)(ws + O_WIN1) + ((size_t)l * 10240 + r0) * 2048, 2048, kt * 256, tile, tid); }
        else { r0 -= 10240; const int col = r0 < 1024 ? r0 + 2048 : r0 + 3088;
            tconv_item(src, NIN, col, (bf16_t*)(ws + O_WIN2) + ((size_t)l * 4096 + r0) * 2048, 2048, kt * 256, tile, tid); }
        return;
    }
    it -= 1792;
    if (it < 128) { const int rt = it >> 2, kt = it & 3; tconv_item(p.in[I_WMO] + (size_t)l * BW * DM, DM, rt * 64, (bf16_t*)(ws + O_WA) + ((size_t)l * 2048 + rt * 64) * 1024, 1024, kt * 256, tile, tid); return; }
    it -= 128;
    if (it < 128) { const int rt = it >> 2, kt = it & 3; tconv_item(p.in[I_WHO] + (size_t)l * BW * DM, DM, rt * 64, (bf16_t*)(ws + O_WB) + ((size_t)l * 2048 + rt * 64) * 1024, 1024, kt * 256, tile, tid); return; }
    it -= 128;
    if (it < 256) { const int rt = it >> 2, kt = it & 3, r0 = rt * 64, u = r0 >> 8, w = r0 & 255; const int col = w < 128 ? 128 * u + w : 2048 + 128 * u + (w - 128);
        tconv_item(p.in[I_WSG] + (size_t)l * BW * 4096, 4096, col, (bf16_t*)(ws + O_WC) + ((size_t)l * 4096 + r0) * 1024, 1024, kt * 256, tile, tid); return; }
    it -= 256;
    { const int rt = it >> 3, kt = it & 7; tconv_item(p.in[I_WOUT] + (size_t)l * DM * DM, DM, rt * 64, (bf16_t*)(ws + O_WO) + ((size_t)l * 2048 + rt * 64) * 2048, 2048, kt * 256, tile, tid); }
}
DI bf16x8 ld8_bf16(const float* __restrict__ src) { const f32x4 a = *(const f32x4*)src, b = *(const f32x4*)(src + 4);
    return __builtin_bit_cast(bf16x8, (u32x4){pk_bf16(a[0], a[1]), pk_bf16(a[2], a[3]), pk_bf16(b[0], b[1]), pk_bf16(b[2], b[3])}); }
DI void ws_item(const Params& p, int item, int tid) {
    const int l = item >> 8, hc = (item >> 4) & 15, dt = item & 15;
    const int wid = __builtin_amdgcn_readfirstlane(tid >> 6), lane = tid & 63, fr = lane & 15, fq = lane >> 4;
    const float* sk = p.in[I_PSK] + ((size_t)l * 16 + hc) * 16384 + fr * 128 + 8 * fq;
    const float* wq = p.in[I_PWQ] + (size_t)l * DM * DM + (size_t)(128 * dt + 16 * wid + fr) * DM + hc * 128 + 8 * fq;
    f32x4 acc[8];
#pragma unroll
    for (int m = 0; m < 8; ++m) acc[m] = (f32x4){0.f, 0.f, 0.f, 0.f};
#pragma unroll
    for (int ks = 0; ks < 4; ++ks) { const bf16x8 bfr = ld8_bf16(wq + 32 * ks);
#pragma unroll
        for (int m = 0; m < 8; ++m) acc[m] = __builtin_amdgcn_mfma_f32_16x16x32_bf16(ld8_bf16(sk + (16 * m) * 128 + 32 * ks), bfr, acc[m], 0, 0, 0); }
    const int dcol = 128 * dt + 16 * wid + fr;
    const float gam = p.in[I_L1G][l * DM + dcol], bet = p.in[I_L1B][l * DM + dcol];
    bf16_t* dst = (bf16_t*)(p.ws + O_WS) + ((size_t)l * 2048 + hc * 128 + 4 * fq) * 2048 + dcol;
    float* c1p = (float*)(p.ws + O_C1P) + ((size_t)l * 2048 + hc * 128 + 4 * fq) * 128 + dt * 8 + wid;
    float* c2p = (float*)(p.ws + O_C2P) + ((size_t)l * 2048 + hc * 128 + 4 * fq) * 128 + dt * 8 + wid;
#pragma unroll
    for (int m = 0; m < 8; ++m)
#pragma unroll
        for (int j = 0; j < 4; ++j) { const unsigned wb = pk_bf16(acc[m][j] * gam, 0.f) & 0xffffu;
            dst[(size_t)(16 * m + j) * 2048] = (bf16_t)wb;
            float s1 = __uint_as_float(wb << 16), s2 = acc[m][j] * bet;
            s1 += __shfl_xor(s1, 1); s1 += __shfl_xor(s1, 2); s1 += __shfl_xor(s1, 4); s1 += __shfl_xor(s1, 8);
            s2 += __shfl_xor(s2, 1); s2 += __shfl_xor(s2, 2); s2 += __shfl_xor(s2, 4); s2 += __shfl_xor(s2, 8);
            if (fr == 0) { c1p[(size_t)(16 * m + j) * 128] = s1; c2p[(size_t)(16 * m + j) * 128] = s2; } }
}
DI void hid2_item(const Params& p, int item, int lane) {
    const int l = item >> 13, t = item & 8191;
    const float* w1 = p.in[I_HW1] + (size_t)l * 33 * 64; const float* w2 = p.in[I_HW2] + (size_t)l * 64 * 64;
    float cs = 0.f, sn = 0.f;
    { const int i = lane & 15; const double band = 1e-4 + (double)i * ((15.0 - 1e-4) / 15.0); double r = (double)t * band / 8192.0; r -= floor(r);
      const float fr = (float)r; sincospif(2.0f * fr, &sn, &cs); }
    float acc = p.in[I_HB1][l * 64 + lane] + ((float)t / 8191.0f) * w1[lane];
#pragma unroll
    for (int i = 0; i < 16; ++i) { const float c = __shfl(cs, i), s = __shfl(sn, i); acc += c * w1[(1 + i) * 64 + lane] - s * w1[(17 + i) * 64 + lane]; }
    const float h1 = sinf(p.in[I_HFQ][(l * 2 + 0) * 64 + lane] * acc);
    float acc2 = p.in[I_HB2][l * 64 + lane];
#pragma unroll 16
    for (int i = 0; i < 64; ++i) acc2 += __shfl(h1, i) * w2[i * 64 + lane];
    const float h2 = sinf(p.in[I_HFQ][(l * 2 + 1) * 64 + lane] * acc2);
    const float h2n = __shfl_down(h2, 1);
    if ((lane & 1) == 0) ((unsigned*)(p.ws + O_HID2))[(((size_t)l * 8192 + t) * 64 + lane) >> 1] = pk_bf16(h2, h2n);
}

constexpr int FN = 16384;
DI int rev4_14(int k) { unsigned v = __brev((unsigned)k) >> 18; return (int)(((v & 0x2AAAu) >> 1) | ((v & 0x1555u) << 1)); }
DI int SW(int e) { const int h = e >> 5; return e ^ ((h ^ (h << 1)) & 31); }
struct FftTw { cf2 a0[3], b0[3], sa[3], sb[3], a2[3], b2[3], a4[3], b4[3]; };
DI void fft_load_tw(FftTw& t, const cf2* __restrict__ tw, int tid) {
#pragma unroll
    for (int k = 1; k <= 3; ++k) {
        t.a0[k - 1] = tw[tid * k]; t.b0[k - 1] = tw[4 * tid * k]; t.sa[k - 1] = tw[512 * k]; t.sb[k - 1] = tw[2048 * k];
        const int j2 = tid & 63, j4 = tid & 3;
        t.a2[k - 1] = tw[j2 * 16 * k]; t.b2[k - 1] = tw[j2 * 64 * k]; t.a4[k - 1] = tw[j4 * 256 * k]; t.b4[k - 1] = tw[j4 * 1024 * k];
    }
}
DI cf2 cmulk(cf2 z, float cr, float ci) { return mk2(z.x * cr - z.y * ci, z.x * ci + z.y * cr); }
template <int n, bool CONJ> DI cf2 mulw16(cf2 z) {
    constexpr float C1 = 0.9238795325112867f, S1 = 0.3826834323650898f, H = 0.7071067811865476f;
    constexpr float sg = CONJ ? -1.0f : 1.0f;
    if (n == 1) return cmulk(z, C1, -S1 * sg);
    if (n == 2) return cmulk(z, H, -H * sg);
    if (n == 3) return cmulk(z, S1, -C1 * sg);
    if (n == 4) return CONJ ? mk2(-z.y, z.x) : mk2(z.y, -z.x);
    if (n == 6) return cmulk(z, -H, -H * sg);
    return cmulk(z, -C1, S1 * sg);
}
DI void bfly_f(cf2& x0, cf2& x1, cf2& x2, cf2& x3) {
    const cf2 a0 = x0 + x2, a1 = x0 - x2, a2 = x1 + x3, a3 = x1 - x3;
    x0 = a0 + a2; x2 = a0 - a2; x1 = mk2(a1.x + a3.y, a1.y - a3.x); x3 = mk2(a1.x - a3.y, a1.y + a3.x);
}
DI void bfly_i(cf2& u0, cf2& u1, cf2& u2, cf2& u3) {
    const cf2 b0 = u0 + u2, b1 = u0 - u2, b2 = u1 + u3, b3 = u1 - u3;
    u0 = b0 + b2; u2 = b0 - b2; u1 = mk2(b1.x - b3.y, b1.y + b3.x); u3 = mk2(b1.x + b3.y, b1.y - b3.x);
}
template <int P, bool INV>
DI void fft_pass16(LAS cf2* x, const FftTw& tw, int tid) {
    constexpr int lq1 = 12 - 2 * (P + 1), q1 = 1 << lq1, q0 = 4 * q1;
    cf2 wa[3], wb[3];
#pragma unroll
    for (int k = 0; k < 3; ++k) { wa[k] = P == 0 ? tw.a0[k] : (P == 2 ? tw.a2[k] : tw.a4[k]); wb[k] = P == 0 ? tw.b0[k] : (P == 2 ? tw.b2[k] : tw.b4[k]); }
#pragma unroll 1
    for (int i = 0; i < 2; ++i) {
        const int gp = tid + 512 * i, jp = gp & (q1 - 1), base = ((gp >> lq1) << (lq1 + 4)) + jp;
        cf2 t[4][4];
#pragma unroll
        for (int m1 = 0; m1 < 4; ++m1)
#pragma unroll
            for (int m2 = 0; m2 < 4; ++m2) t[m1][m2] = x[SW(base + m1 * q0 + m2 * q1)];
        if (!INV) {
#pragma unroll
            for (int m2 = 0; m2 < 4; ++m2) { bfly_f(t[0][m2], t[1][m2], t[2][m2], t[3][m2]);
                t[1][m2] = cmul(t[1][m2], wa[0]); t[2][m2] = cmul(t[2][m2], wa[1]); t[3][m2] = cmul(t[3][m2], wa[2]); }
            t[1][1] = mulw16<1, false>(t[1][1]); t[2][1] = mulw16<2, false>(t[2][1]); t[3][1] = mulw16<3, false>(t[3][1]);
            t[1][2] = mulw16<2, false>(t[1][2]); t[2][2] = mulw16<4, false>(t[2][2]); t[3][2] = mulw16<6, false>(t[3][2]);
            t[1][3] = mulw16<3, false>(t[1][3]); t[2][3] = mulw16<6, false>(t[2][3]); t[3][3] = mulw16<9, false>(t[3][3]);
#pragma unroll
            for (int k1 = 0; k1 < 4; ++k1) { bfly_f(t[k1][0], t[k1][1], t[k1][2], t[k1][3]);
                t[k1][1] = cmul(t[k1][1], wb[0]); t[k1][2] = cmul(t[k1][2], wb[1]); t[k1][3] = cmul(t[k1][3], wb[2]); }
        } else {
#pragma unroll
            for (int k1 = 0; k1 < 4; ++k1) { t[k1][1] = cmulc(t[k1][1], wb[0]); t[k1][2] = cmulc(t[k1][2], wb[1]); t[k1][3] = cmulc(t[k1][3], wb[2]);
                bfly_i(t[k1][0], t[k1][1], t[k1][2], t[k1][3]); }
            t[1][1] = mulw16<1, true>(t[1][1]); t[2][1] = mulw16<2, true>(t[2][1]); t[3][1] = mulw16<3, true>(t[3][1]);
            t[1][2] = mulw16<2, true>(t[1][2]); t[2][2] = mulw16<4, true>(t[2][2]); t[3][2] = mulw16<6, true>(t[3][2]);
            t[1][3] = mulw16<3, true>(t[1][3]); t[2][3] = mulw16<6, true>(t[2][3]); t[3][3] = mulw16<9, true>(t[3][3]);
#pragma unroll
            for (int m2 = 0; m2 < 4; ++m2) { t[1][m2] = cmulc(t[1][m2], wa[0]); t[2][m2] = cmulc(t[2][m2], wa[1]); t[3][m2] = cmulc(t[3][m2], wa[2]);
                bfly_i(t[0][m2], t[1][m2], t[2][m2], t[3][m2]); }
        }
#pragma unroll
        for (int m1 = 0; m1 < 4; ++m1)
#pragma unroll
            for (int m2 = 0; m2 < 4; ++m2) x[SW(base + m1 * q0 + m2 * q1)] = t[m1][m2];
        if (P == 0) {
#pragma unroll
            for (int k = 0; k < 3; ++k) { wa[k] = cmul(wa[k], tw.sa[k]); wb[k] = cmul(wb[k], tw.sb[k]); }
        }
    }
    __syncthreads();
}
template <bool INV>
DI void fft_pass4_last(LAS cf2* x, int tid) {
#pragma unroll 4
    for (int i = 0; i < 8; ++i) { const int b4 = 4 * (tid + 512 * i);
        const int e0 = SW(b4), e1 = SW(b4 + 1), e2 = SW(b4 + 2), e3 = SW(b4 + 3);
        cf2 x0 = x[e0], x1 = x[e1], x2 = x[e2], x3 = x[e3];
        if (!INV) bfly_f(x0, x1, x2, x3); else bfly_i(x0, x1, x2, x3);
        x[e0] = x0; x[e1] = x1; x[e2] = x2; x[e3] = x3; }
    __syncthreads();
}
DI void fft_fwd(LAS cf2* x, const FftTw& t, int tid) { fft_pass16<0, false>(x, t, tid); fft_pass16<2, false>(x, t, tid); fft_pass16<4, false>(x, t, tid); fft_pass4_last<false>(x, tid); }
DI void fft_inv(LAS cf2* x, const FftTw& t, int tid) { fft_pass4_last<true>(x, tid); fft_pass16<4, true>(x, t, tid); fft_pass16<2, true>(x, t, tid); fft_pass16<0, true>(x, t, tid); }
DI void ftap_item(const Params& p, int item, int tid) {
    const int l = item >> 6, ct = item & 63, wid = __builtin_amdgcn_readfirstlane(tid >> 6), lane = tid & 63, fr = lane & 15, fq = lane >> 4;
    bf16x8 wh[2][2], wl[2][2];
#pragma unroll
    for (int c2 = 0; c2 < 2; ++c2) { const float* w3 = p.in[I_HW3] + (size_t)l * 64 * 2048 + ct * 32 + 16 * c2 + fr;
#pragma unroll
        for (int ks = 0; ks < 2; ++ks) { float v[8]; u32x4 h, lo;
#pragma unroll
            for (int j = 0; j < 8; ++j) v[j] = w3[(size_t)(32 * ks + 8 * fq + j) * 2048];
#pragma unroll
            for (int e = 0; e < 4; ++e) { h[e] = pk_bf16(v[2 * e], v[2 * e + 1]); lo[e] = pk_bf16(v[2 * e] - bf_lo(h[e]), v[2 * e + 1] - bf_hi(h[e])); }
            wh[c2][ks] = __builtin_bit_cast(bf16x8, h); wl[c2][ks] = __builtin_bit_cast(bf16x8, lo); } }
    const bf16_t* hid = (const bf16_t*)(p.ws + O_HID2) + ((size_t)l * 8192 + 1024 * wid + fr) * 64 + 8 * fq;
    float* ft = (float*)(p.ws + O_FT) + ((size_t)l * 2048 + ct * 32 + fr) * 8192 + 1024 * wid + 4 * fq;
#pragma unroll 4
    for (int i = 0; i < 64; ++i) {
        const bf16x8 a0 = *(const bf16x8*)(hid + (size_t)(16 * i) * 64), a1 = *(const bf16x8*)(hid + (size_t)(16 * i) * 64 + 32);
#pragma unroll
        for (int c2 = 0; c2 < 2; ++c2) { f32x4 acc = (f32x4){0.f, 0.f, 0.f, 0.f};
            acc = __builtin_amdgcn_mfma_f32_16x16x32_bf16(a0, wh[c2][0], acc, 0, 0, 0); acc = __builtin_amdgcn_mfma_f32_16x16x32_bf16(a0, wl[c2][0], acc, 0, 0, 0);
            acc = __builtin_amdgcn_mfma_f32_16x16x32_bf16(a1, wh[c2][1], acc, 0, 0, 0); acc = __builtin_amdgcn_mfma_f32_16x16x32_bf16(a1, wl[c2][1], acc, 0, 0, 0);
            *(f32x4*)(ft + (size_t)(16 * c2) * 8192 + 16 * i) = acc; }
    }
}
DI void filt_item(const Params& p, int item, LAS unsigned char* lds, int tid) {
    __syncthreads();
    const int l = item >> 9, pr = item & 511, c1 = 2 * pr;
    LAS cf2* buf = (LAS cf2*)lds; LAS float* red = (LAS float*)(lds + 131072);
    const cf2* tw = (const cf2*)(p.ws + O_TW);
    FftTw ftw; fft_load_tw(ftw, tw, tid);
    const int q = tid >> 7, tl = tid & 127, wid = __builtin_amdgcn_readfirstlane(tid >> 6);
    const float dec = fabsf(p.in[I_HDC][((size_t)l * 2 + (q >> 1)) * 1024 + c1 + (q & 1)]);
    const float* ftc = (const float*)(p.ws + O_FT) + ((size_t)l * 2048 + (q >> 1) * 1024 + c1 + (q & 1)) * 8192 + 4 * tl;
    float we[4];
#pragma unroll
    for (int e = 0; e < 4; ++e) we[e] = expf(-((float)(4 * tl + e) / 8191.0f) * dec);
    const float wstep = expf(-(512.0f / 8191.0f) * dec);
    float wt = 1.0f, asum = 0.f;
    LAS float* bufs = (LAS float*)buf;
#pragma unroll 4
    for (int i = 0; i < 16; ++i) { const int t0 = 4 * tl + 512 * i; const f32x4 fv = *(const f32x4*)(ftc + 512 * i);
#pragma unroll
        for (int e = 0; e < 4; ++e) { const int t = t0 + e; const float f = fv[e] * (wt * we[e]); asum += fabsf(f);
            if (q < 2) bufs[2 * SW(t) + q] = f; else if (t >= 1) bufs[2 * SW(FN - t) + (q - 2)] = f; }
        wt *= wstep; }
    if (tid == 0) buf[SW(8192)] = mk2(0.f, 0.f);
    { const float sq = wave_sum(asum); if ((tid & 63) == 0) red[wid] = sq; }
    __syncthreads();
    float sc[4];
#pragma unroll
    for (int qq = 0; qq < 4; ++qq) sc[qq] = 1.0f / (red[2 * qq] + red[2 * qq + 1] + 1e-6f);
#pragma unroll 2
    for (int i = 0; i < 32; ++i) { const int n = tid + 512 * i; cf2 v = buf[SW(n)]; if (n < 8192) { v.x *= sc[0]; v.y *= sc[1]; } else { v.x *= sc[2]; v.y *= sc[3]; } buf[SW(n)] = v; }
    __syncthreads();
    fft_fwd(buf, ftw, tid);
    f32x4* pm = (f32x4*)(p.ws + O_PM) + ((size_t)l * 512 + pr) * PM_STRIDE;
    const float inv = 1.0f / (2.0f * 16384.0f);
#pragma unroll 1
    for (int i = 0; i < 17; ++i) { const int k = tid + 512 * i; if (k > 8192) break;
        const cf2 A = buf[SW(rev4_14(k))], B = buf[SW(rev4_14((FN - k) & (FN - 1)))];
        const float h1x = 0.5f * (A.x + B.x), h1y = 0.5f * (A.y - B.y), h2x = 0.5f * (A.y + B.y), h2y = -0.5f * (A.x - B.x);
        pm[k] = (f32x4){(h1x + h2x) * inv, (h1y + h2y) * inv, (h1x - h2x) * inv, (h1y - h2y) * inv}; }
    __syncthreads();
}
DI void conv3x8(const bf16_t* __restrict__ row, int t0, float w0, float w1, float w2, float b, float (&o)[8]) {
    const u32x4 cw = *(const u32x4*)(row + t0);
    float c[10];
    c[0] = t0 > 0 ? __uint_as_float(((unsigned)row[t0 - 1]) << 16) : 0.f;
    c[9] = t0 + 8 < T ? __uint_as_float(((unsigned)row[t0 + 8]) << 16) : 0.f;
#pragma unroll
    for (int e = 0; e < 4; ++e) { c[1 + 2 * e] = bf_lo(cw[e]); c[2 + 2 * e] = bf_hi(cw[e]); }
#pragma unroll
    for (int e = 0; e < 8; ++e) o[e] = w0 * c[e] + w1 * c[e + 1] + w2 * c[e + 2] + b;
}
DI void hyena_item(const Params& p, int l, int pr, LAS unsigned char* lds, int tid) {
    __syncthreads();
    LAS cf2* buf = (LAS cf2*)lds;
    const cf2* tw = (const cf2*)(p.ws + O_TW);
    FftTw ftw; fft_load_tw(ftw, tw, tid);
    const bf16_t* hpt = (const bf16_t*)(p.ws + O_HPT);
    const float* cw = p.in[I_HCW] + (size_t)l * 3 * 3072; const float* cb = p.in[I_HCB] + (size_t)l * 3072;
    const int c1 = 2 * pr;
    float w[6][4];
#pragma unroll
    for (int s = 0; s < 3; ++s)
#pragma unroll
        for (int e = 0; e < 2; ++e) { const int ch = s * 1024 + c1 + e; w[s * 2 + e][0] = cw[ch]; w[s * 2 + e][1] = cw[3072 + ch]; w[s * 2 + e][2] = cw[6144 + ch]; w[s * 2 + e][3] = cb[ch]; }
    const bf16_t* r_x0a = hpt + (size_t)(c1) * T;        const bf16_t* r_x0b = r_x0a + T;
    const bf16_t* r_x1a = hpt + (size_t)(1024 + c1) * T; const bf16_t* r_x1b = r_x1a + T;
    const bf16_t* r_va  = hpt + (size_t)(2048 + c1) * T; const bf16_t* r_vb  = r_va + T;
#pragma unroll 1
    for (int i = 0; i < 2; ++i) { const int t0 = 8 * tid + 4096 * i;
        float xa[8], va[8], xb[8], vb[8];
        conv3x8(r_x1a, t0, w[2][0], w[2][1], w[2][2], w[2][3], xa); conv3x8(r_va, t0, w[4][0], w[4][1], w[4][2], w[4][3], va);
        conv3x8(r_x1b, t0, w[3][0], w[3][1], w[3][2], w[3][3], xb); conv3x8(r_vb, t0, w[5][0], w[5][1], w[5][2], w[5][3], vb);
#pragma unroll
        for (int e = 0; e < 8; ++e) { buf[SW(t0 + e)] = mk2(xa[e] * va[e], xb[e] * vb[e]); buf[SW(t0 + e + 8192)] = mk2(0.f, 0.f); } }
    __syncthreads();
    fft_fwd(buf, ftw, tid);
    const f32x4* pm = (const f32x4*)(p.ws + O_PM) + ((size_t)l * 512 + pr) * PM_STRIDE;
#pragma unroll 4
    for (int i = 0; i < 16; ++i) { const int k = tid + 512 * i;
        const int pk = SW(rev4_14(k)), pnk = SW(rev4_14((FN - k) & (FN - 1)));
        const cf2 A = buf[pk], B = buf[pnk]; const f32x4 PMv = pm[k];
        const cf2 P = mk2(PMv[0], PMv[1]), M = mk2(PMv[2], PMv[3]);
        const cf2 Yk = mk2(A.x * P.x - A.y * P.y + B.x * M.x + B.y * M.y, A.x * P.y + A.y * P.x + B.x * M.y - B.y * M.x);
        const cf2 Yn = mk2(B.x * P.x + B.y * P.y + A.x * M.x - A.y * M.y, B.y * P.x - B.x * P.y - A.x * M.y - A.y * M.x);
        buf[pk] = Yk; if (pnk != pk) buf[pnk] = Yn; }
    if (tid == 0) { const int pk = SW(rev4_14(8192)); const cf2 A = buf[pk]; const f32x4 PMv = pm[8192];
        buf[pk] = mk2(A.x * PMv[0] - A.y * PMv[1] + A.x * PMv[2] + A.y * PMv[3], A.x * PMv[1] + A.y * PMv[0] + A.x * PMv[3] - A.y * PMv[2]); }
    __syncthreads();
    fft_inv(buf, ftw, tid);
    const float ska = p.in[I_HSK][l * 1024 + c1], skb = p.in[I_HSK][l * 1024 + c1 + 1];
    bf16_t* yht = (bf16_t*)(p.ws + O_KT);
#pragma unroll 1
    for (int i = 0; i < 2; ++i) { const int t0 = 8 * tid + 4096 * i;
        float xa[8], va[8], xb[8], vb[8], ga[8], gb[8];
        conv3x8(r_x1a, t0, w[2][0], w[2][1], w[2][2], w[2][3], xa); conv3x8(r_va, t0, w[4][0], w[4][1], w[4][2], w[4][3], va);
        conv3x8(r_x1b, t0, w[3][0], w[3][1], w[3][2], w[3][3], xb); conv3x8(r_vb, t0, w[5][0], w[5][1], w[5][2], w[5][3], vb);
        conv3x8(r_x0a, t0, w[0][0], w[0][1], w[0][2], w[0][3], ga); conv3x8(r_x0b, t0, w[1][0], w[1][1], w[1][2], w[1][3], gb);
        float oa[8], ob[8];
#pragma unroll
        for (int e = 0; e < 8; ++e) { const cf2 y = buf[SW(t0 + e)]; oa[e] = ga[e] * (y.x + ska * xa[e] * va[e]); ob[e] = gb[e] * (y.y + skb * xb[e] * vb[e]); }
        *(u32x4*)(yht + (size_t)c1 * T + t0) = (u32x4){pk_bf16(oa[0], oa[1]), pk_bf16(oa[2], oa[3]), pk_bf16(oa[4], oa[5]), pk_bf16(oa[6], oa[7])};
        *(u32x4*)(yht + (size_t)(c1 + 1) * T + t0) = (u32x4){pk_bf16(ob[0], ob[1]), pk_bf16(ob[2], ob[3]), pk_bf16(ob[4], ob[5]), pk_bf16(ob[6], ob[7])}; }
    __syncthreads();
}
DI void yh_transpose_item(const Params& p, int item, LAS unsigned char* lds, int tid) {
    __syncthreads();
    const int c0 = (item & 15) * 64, t0 = (item >> 4) * 64;
    LAS bf16_t* tile = (LAS bf16_t*)lds;
    { const int c = tid >> 3, seg = tid & 7;
      *(LAS u32x4*)(tile + c * 72 + 8 * seg) = *(const u32x4*)((const bf16_t*)(p.ws + O_KT) + (size_t)(c0 + c) * T + t0 + 8 * seg); }
    __syncthreads();
    { const int t = tid >> 3, seg = tid & 7; unsigned w[4];
#pragma unroll
      for (int j = 0; j < 4; ++j) w[j] = (unsigned)tile[(8 * seg + 2 * j) * 72 + t] | ((unsigned)tile[(8 * seg + 2 * j + 1) * 72 + t] << 16);
      *(u32x4*)((bf16_t*)(p.ws + O_YH) + (size_t)(t0 + t) * 1024 + c0 + 8 * seg) = (u32x4){w[0], w[1], w[2], w[3]}; }
}

constexpr int MC_KS = 528, MC_VS = 272, MC_PS = 272;
DI float mlstm_gates(const Params& p, int l, int dir, int head, int t_base, LAS float* li, LAS float* bb, int lane) {
    const float* MG = (const float*)(p.ws + O_MG); const float* bias = p.in[I_MGB] + l * 16;
    float lfv[2], liv[2];
#pragma unroll
    for (int u = 0; u < 2; ++u) { const int r = 2 * lane + u, rho = dir ? 127 - r : r, t = t_base + rho;
        const float gi = MG[t * 16 + dir * 8 + head] + bias[dir * 8 + head], gf = MG[t * 16 + dir * 8 + 4 + head] + bias[dir * 8 + 4 + head];
        liv[u] = gi; lfv[u] = fminf(gf, 0.f) - log1pf(expf(-fabsf(gf))); }
    const float s1 = lfv[0] + lfv[1];
    const float inc = wave_scan_add(s1, lane), exc = inc - s1;
    bb[2 * lane] = exc + lfv[0]; bb[2 * lane + 1] = inc; li[2 * lane] = liv[0]; li[2 * lane + 1] = liv[1];
    return inc;
}
DI u32x4 tr_read2(unsigned a0, unsigned a1) { u32x2 lo, hi;
    asm volatile("ds_read_b64_tr_b16 %0, %2\n\tds_read_b64_tr_b16 %1, %3\n\ts_waitcnt lgkmcnt(0)" : "=&v"(lo), "=&v"(hi) : "v"(a0), "v"(a1) : "memory");
    return (u32x4){lo[0], lo[1], hi[0], hi[1]}; }
DI void mlstm_passA(const Params& p, int l, int item, LAS unsigned char* lds, int tid) {
    __syncthreads();
    const int dir = item >> 8, head = (item >> 6) & 3, cv = item & 63, cact = dir ? 63 - cv : cv, t_base = cact * 128;
    const int wid = __builtin_amdgcn_readfirstlane(tid >> 6), lane = tid & 63;
    LAS unsigned char* Kl = lds;
    LAS float* li = (LAS float*)(lds + 128 * MC_KS); LAS float* bb = li + 128; LAS float* wact = bb + 128;
    if (wid == 0) {
        const float inc = mlstm_gates(p, l, dir, head, t_base, li, bb, lane);
        const float blast = __shfl(inc, 63);
        const float lw0 = blast - bb[2 * lane] + li[2 * lane], lw1 = blast - bb[2 * lane + 1] + li[2 * lane + 1];
        const float ml = wave_max(fmaxf(lw0, lw1));
        const int r0 = 2 * lane, r1 = 2 * lane + 1;
        wact[dir ? 127 - r0 : r0] = expf(lw0 - ml); wact[dir ? 127 - r1 : r1] = expf(lw1 - ml);
        if (lane == 0) { ((float*)(p.ws + O_MLOC))[item] = ml; ((float*)(p.ws + O_BLAST))[item] = blast; }
    }
    { const bf16_t* Kg = (const bf16_t*)(p.ws + O_K) + (size_t)t_base * 1024 + head * 256;
#pragma unroll
      for (int i = 0; i < 8; ++i) { const int idx = tid + 512 * i, rho = idx >> 5, c16 = idx & 31;
          *(LAS u32x4*)(Kl + rho * MC_KS + c16 * 16) = *(const u32x4*)(Kg + (size_t)rho * 1024 + c16 * 8); } }
    __syncthreads();
    const bf16_t* VT = (const bf16_t*)(p.ws + O_VT) + (size_t)head * 256 * T + t_base;
    const int wr = wid >> 1, wc = wid & 1, rl = lane & 15, g = lane >> 4;
    const unsigned kbase = (unsigned)(size_t)Kl + (unsigned)((8 * g + (rl >> 2)) * MC_KS + (128 * wc + 4 * (rl & 3)) * 2);
    f32x4 acc[4][8];
#pragma unroll
    for (int a = 0; a < 4; ++a)
#pragma unroll
        for (int b = 0; b < 8; ++b) acc[a][b] = (f32x4){0.f, 0.f, 0.f, 0.f};
#pragma unroll 1
    for (int ks = 0; ks < 4; ++ks) {
        const int rho0 = 32 * ks + 8 * g;
        float wv[8];
#pragma unroll
        for (int j = 0; j < 8; ++j) wv[j] = wact[rho0 + j];
        bf16x8 af[4];
#pragma unroll
        for (int mt = 0; mt < 4; ++mt) af[mt] = *(const bf16x8*)(VT + (size_t)(64 * wr + 16 * mt + rl) * T + rho0);
#pragma unroll
        for (int nt = 0; nt < 8; ++nt) {
            const unsigned a0 = kbase + (unsigned)(32 * ks * MC_KS + 32 * nt);
            const u32x4 kw = tr_read2(a0, a0 + 4 * MC_KS);
            u32x4 sw;
#pragma unroll
            for (int q = 0; q < 4; ++q) sw[q] = pk_bf16(bf_lo(kw[q]) * wv[2 * q], bf_hi(kw[q]) * wv[2 * q + 1]);
            const bf16x8 bfr = __builtin_bit_cast(bf16x8, sw);
#pragma unroll
            for (int mt = 0; mt < 4; ++mt) acc[mt][nt] = __builtin_amdgcn_mfma_f32_16x16x32_bf16(bfr, af[mt], acc[mt][nt], 0, 0, 0);
        }
    }
    bf16_t* KVu = (bf16_t*)(p.ws + O_KV) + (size_t)item * 65536 + (64 * wr) * 256 + 128 * wc;
    const int loff = rl * 256 + 4 * g;
#pragma unroll
    for (int mt = 0; mt < 4; ++mt) { bf16_t* rowp = KVu + (16 * mt) * 256;
#pragma unroll
        for (int nt = 0; nt < 8; ++nt) *(u32x2*)(rowp + loff + 16 * nt) = (u32x2){pk_bf16(acc[mt][nt][0], acc[mt][nt][1]), pk_bf16(acc[mt][nt][2], acc[mt][nt][3])}; }
    if (tid < 256) { float s = 0.f;
#pragma unroll 8
        for (int rho = 0; rho < 128; ++rho) s += wact[rho] * __uint_as_float(((unsigned)*(const LAS bf16_t*)(Kl + rho * MC_KS + 2 * tid)) << 16);
        ((float*)(p.ws + O_NLOC))[(size_t)item * 256 + tid] = s; }
    __syncthreads();
}
DI void mlstm_passB(const Params& p, int gtid, int gthreads, int bid, int tid) {
    const float* MLOC = (const float*)(p.ws + O_MLOC); const float* BLAST = (const float*)(p.ws + O_BLAST);
    if (tid >= 64 && tid < 66 && bid * 2 + (tid - 64) < 512) {
        const int v = bid * 2 + (tid - 64), dh = v >> 6, off = (v & 63) * 4;
        const float* NL_ = (const float*)(p.ws + O_NLOC) + (size_t)dh * 64 * 256 + off;
        float* NST = (float*)(p.ws + O_NST) + (size_t)dh * 64 * 256 + off;
        f32x4 n = (f32x4){0.f, 0.f, 0.f, 0.f}; float m = 0.f;
#pragma unroll 1
        for (int c0 = 0; c0 < 64; c0 += 16) {
            f32x4 nl[16]; float bl[16], ml[16];
#pragma unroll
            for (int k = 0; k < 16; ++k) { nl[k] = *(const f32x4*)(NL_ + (size_t)(c0 + k) * 256); bl[k] = BLAST[dh * 64 + c0 + k]; ml[k] = MLOC[dh * 64 + c0 + k]; }
#pragma unroll
            for (int k = 0; k < 16; ++k) { const int c = c0 + k;
                *(f32x4*)(NST + (size_t)c * 256) = n;
                if (off == 0) ((float*)(p.ws + O_MST))[dh * 64 + c] = m;
                const float mn = fmaxf(bl[k] + m, ml[k]);
                n = expf(bl[k] + m - mn) * n + expf(ml[k] - mn) * nl[k]; m = mn; }
        }
    }
    for (int w = gtid; w < 8 * 16384; w += gthreads) {
        const int dh = w >> 14, off = (w & 16383) * 4;
        const bf16_t* KV = (const bf16_t*)(p.ws + O_KV) + (size_t)dh * 64 * 65536 + off;
        bf16_t* CST = (bf16_t*)(p.ws + O_CST) + (size_t)dh * 64 * 65536 + off;
        f32x4 C = (f32x4){0.f, 0.f, 0.f, 0.f}; float m = 0.f;
#pragma unroll 1
        for (int c0 = 0; c0 < 64; c0 += 16) {
            u32x2 kw[16];
#pragma unroll
            for (int k = 0; k < 16; ++k) kw[k] = *(const u32x2*)(KV + (size_t)(c0 + k) * 65536);
#pragma unroll
            for (int k = 0; k < 16; ++k) { const int c = c0 + k; const f32x4 kv = (f32x4){bf_lo(kw[k][0]), bf_hi(kw[k][0]), bf_lo(kw[k][1]), bf_hi(kw[k][1])};
                *(u32x2*)(CST + (size_t)c * 65536) = (u32x2){pk_bf16(C[0], C[1]), pk_bf16(C[2], C[3])};
                const float bl = BLAST[dh * 64 + c], ml = MLOC[dh * 64 + c], mn = fmaxf(bl + m, ml);
                const float dk = expf(bl + m - mn), sk = expf(ml - mn);
                C = dk * C + sk * kv; m = mn; }
        }
    }
}
DI void mlstm_passC(const Params& p, int l, int item, LAS unsigned char* lds, int tid) {
    __syncthreads();
    const int dir = item >> 8, head = (item >> 6) & 3, cv = item & 63, cact = dir ? 63 - cv : cv, t_base = cact * 128;
    const int wid = __builtin_amdgcn_readfirstlane(tid >> 6), lane = tid & 63, rl = lane & 15, g = lane >> 4;
    constexpr int RA = 256 * MC_VS;
    LAS unsigned char* Kl = lds;
    LAS unsigned char* Vl = lds;
    LAS unsigned char* Pw = lds + RA + wid * 16 * MC_PS;
    LAS float* sc = (LAS float*)(lds + 2 * RA);
    LAS float* li = sc; LAS float* bb = sc + 128; LAS float* av = sc + 256; LAS float* Mx = sc + 384; LAS float* inter = sc + 512; LAS float* en = sc + 640;
    LAS float* nst = sc + 768; LAS float* qn = sc + 1024;
    const float mstate = ((const float*)(p.ws + O_MST))[item];
    if (wid == 0) {
        mlstm_gates(p, l, dir, head, t_base, li, bb, lane);
        const float a0 = li[2 * lane] - bb[2 * lane], a1 = li[2 * lane + 1] - bb[2 * lane + 1];
        const float pm = fmaxf(a0, a1), inc = wave_scan_max(pm, lane);
        float exc = __shfl_up(inc, 1); if (lane == 0) exc = -3.0e38f;
        const float M0 = fmaxf(mstate, fmaxf(exc, a0)), M1 = fmaxf(mstate, inc);
        av[2 * lane] = a0; av[2 * lane + 1] = a1; Mx[2 * lane] = M0; Mx[2 * lane + 1] = M1;
        inter[2 * lane] = expf(mstate - M0); inter[2 * lane + 1] = expf(mstate - M1);
        en[2 * lane] = expf(-(bb[2 * lane] + M0)); en[2 * lane + 1] = expf(-(bb[2 * lane + 1] + M1));
    }
    {
        const bf16_t* Kg = (const bf16_t*)(p.ws + O_K) + head * 256;
#pragma unroll
        for (int i = 0; i < 8; ++i) { const int idx = tid + 512 * i, s = idx >> 5, c16 = idx & 31; const int t = t_base + (dir ? 127 - s : s);
            *(LAS u32x4*)(Kl + s * MC_KS + c16 * 16) = *(const u32x4*)(Kg + (size_t)t * 1024 + c16 * 8); }
        if (tid < 256) nst[tid] = ((const float*)(p.ws + O_NST))[(size_t)item * 256 + tid];
    }
    __syncthreads();
    bf16x8 qa[8];
    { const int r = 16 * wid + rl, t = t_base + (dir ? 127 - r : r); const bf16_t* qr = (const bf16_t*)(p.ws + O_Q) + (size_t)t * 1024 + head * 256 + 8 * g;
#pragma unroll
      for (int kk = 0; kk < 8; ++kk) qa[kk] = *(const bf16x8*)(qr + 32 * kk); }
    { float s = 0.f;
#pragma unroll
      for (int kk = 0; kk < 8; ++kk) { const u32x4 w = __builtin_bit_cast(u32x4, qa[kk]);
#pragma unroll
          for (int e = 0; e < 4; ++e) s += bf_lo(w[e]) * nst[32 * kk + 8 * g + 2 * e] + bf_hi(w[e]) * nst[32 * kk + 8 * g + 2 * e + 1]; }
      s += __shfl_xor(s, 16); s += __shfl_xor(s, 32);
      if (g == 0) qn[wid * 16 + rl] = s; }
    float rs[4] = {0.f, 0.f, 0.f, 0.f};
    float Mr[4], ir[4];
#pragma unroll
    for (int j = 0; j < 4; ++j) { Mr[j] = Mx[16 * wid + 4 * g + j]; ir[j] = inter[16 * wid + 4 * g + j]; }
#pragma unroll
    for (int nt = 0; nt < 8; ++nt) if (nt <= wid + 1) {
        f32x4 st = (f32x4){0.f, 0.f, 0.f, 0.f};
        if (nt <= wid) {
#pragma unroll
            for (int kk = 0; kk < 8; ++kk) st = __builtin_amdgcn_mfma_f32_16x16x32_bf16(qa[kk], *(const LAS bf16x8*)(Kl + (16 * nt + rl) * MC_KS + kk * 64 + g * 16), st, 0, 0, 0);
            const int s = 16 * nt + rl; const float as = av[s];
#pragma unroll
            for (int j = 0; j < 4; ++j) { const int r = 16 * wid + 4 * g + j; const float v = (s <= r) ? st[j] * expf(as - Mr[j]) : 0.f; st[j] = v; rs[j] += v; }
        }
#pragma unroll
        for (int j = 0; j < 4; ++j) *(LAS bf16_t*)(Pw + (4 * g + j) * MC_PS + (16 * nt + rl) * 2) = (bf16_t)(pk_bf16(st[j], 0.f) & 0xffffu);
    }
#pragma unroll
    for (int j = 0; j < 4; ++j) { float v = rs[j]; v += __shfl_xor(v, 1); v += __shfl_xor(v, 2); v += __shfl_xor(v, 4); v += __shfl_xor(v, 8); rs[j] = v; }
    f32x4 acc[16];
    const bf16_t* CST = (const bf16_t*)(p.ws + O_CST) + (size_t)item * 65536;
#pragma unroll
    for (int hf = 0; hf < 2; ++hf) {
        __syncthreads();
#pragma unroll
        for (int i = 0; i < 8; ++i) { const int idx = tid + 512 * i, e = idx >> 5, c16 = idx & 31;
            *(LAS u32x4*)(Kl + e * MC_KS + c16 * 16) = *(const u32x4*)(CST + (size_t)(128 * hf + e) * 256 + c16 * 8); }
        __syncthreads();
#pragma unroll
        for (int n8 = 0; n8 < 8; ++n8) { const int n2 = 8 * hf + n8;
            acc[n2] = (f32x4){0.f, 0.f, 0.f, 0.f};
#pragma unroll
            for (int kk = 0; kk < 8; ++kk) acc[n2] = __builtin_amdgcn_mfma_f32_16x16x32_bf16(qa[kk], *(const LAS bf16x8*)(Kl + (16 * n8 + rl) * MC_KS + kk * 64 + g * 16), acc[n2], 0, 0, 0);
#pragma unroll
            for (int j = 0; j < 4; ++j) acc[n2][j] *= ir[j];
        }
    }
    __syncthreads();
    {
        const bf16_t* VT = (const bf16_t*)(p.ws + O_VT) + (size_t)head * 256 * T + t_base;
#pragma unroll
        for (int i = 0; i < 8; ++i) { const int idx = tid + 512 * i, e = idx >> 4, seg = idx & 15;
            u32x4 v = *(const u32x4*)(VT + (size_t)e * T + 8 * seg); int s0 = 8 * seg;
            if (dir) { v = (u32x4){__builtin_rotateleft32(v[3], 16), __builtin_rotateleft32(v[2], 16), __builtin_rotateleft32(v[1], 16), __builtin_rotateleft32(v[0], 16)}; s0 = 120 - 8 * seg; }
            *(LAS u32x4*)(Vl + e * MC_VS + s0 * 2) = v; }
    }
    __syncthreads();
    const int nks = (wid >> 1) + 1;
#pragma unroll
    for (int ks = 0; ks < 4; ++ks) if (ks < nks) {
        const bf16x8 pa = *(const LAS bf16x8*)(Pw + rl * MC_PS + ks * 64 + g * 16);
#pragma unroll
        for (int n2 = 0; n2 < 16; ++n2) acc[n2] = __builtin_amdgcn_mfma_f32_16x16x32_bf16(pa, *(const LAS bf16x8*)(Vl + (16 * n2 + rl) * MC_VS + ks * 64 + g * 16), acc[n2], 0, 0, 0);
    }
    float* HD = (float*)(p.ws + O_HDIR) + (size_t)dir * T * 1024 + head * 256;
#pragma unroll
    for (int j = 0; j < 4; ++j) { const int r = 16 * wid + 4 * g + j, t = t_base + (dir ? 127 - r : r);
        const float den = rs[j] + ir[j] * qn[wid * 16 + 4 * g + j]; const float dd = 1.0f / fmaxf(fabsf(den), en[r]);
#pragma unroll
        for (int n2 = 0; n2 < 16; ++n2) HD[(size_t)t * 1024 + 16 * n2 + rl] = acc[n2][j] * dd; }
    __syncthreads();
}
DI void mlstm_final(const Params& p, int l, int t, int lane) {
    const float* h0 = (const float*)(p.ws + O_HDIR) + (size_t)t * 1024 + 16 * lane; const float* h1 = h0 + (size_t)T * 1024;
    const bf16_t* o = (const bf16_t*)(p.ws + O_O) + (size_t)t * 1024 + 16 * lane; const float* gain = p.in[I_MNG] + l * 1024 + 16 * lane;
    float v[16];
    const u32x4 o0 = *(const u32x4*)o, o1 = *(const u32x4*)(o + 8);
#pragma unroll
    for (int q = 0; q < 4; ++q) { const f32x4 a = *(const f32x4*)(h0 + 4 * q), b = *(const f32x4*)(h1 + 4 * q);
#pragma unroll
        for (int e = 0; e < 4; ++e) v[4 * q + e] = a[e] + b[e]; }
#pragma unroll
    for (int q = 0; q < 4; ++q) { v[2 * q] *= sigmoidf_(bf_lo(o0[q])); v[2 * q + 1] *= sigmoidf_(bf_hi(o0[q])); v[8 + 2 * q] *= sigmoidf_(bf_lo(o1[q])); v[8 + 2 * q + 1] *= sigmoidf_(bf_hi(o1[q])); }
    float s = 0.f;
#pragma unroll
    for (int e = 0; e < 16; ++e) s += v[e];
    s += __shfl_xor(s, 1); s += __shfl_xor(s, 2); s += __shfl_xor(s, 4); s += __shfl_xor(s, 8);
    const float mu = s * (1.0f / 256.0f);
    float q2 = 0.f;
#pragma unroll
    for (int e = 0; e < 16; ++e) { v[e] -= mu; q2 += v[e] * v[e]; }
    q2 += __shfl_xor(q2, 1); q2 += __shfl_xor(q2, 2); q2 += __shfl_xor(q2, 4); q2 += __shfl_xor(q2, 8);
    const float rstd = rsqrtf(q2 * (1.0f / 256.0f) + LN_EPS);
    u32x4 w0, w1;
#pragma unroll
    for (int q = 0; q < 4; ++q) { w0[q] = pk_bf16(v[2 * q] * rstd * gain[2 * q], v[2 * q + 1] * rstd * gain[2 * q + 1]); w1[q] = pk_bf16(v[8 + 2 * q] * rstd * gain[8 + 2 * q], v[9 + 2 * q] * rstd * gain[9 + 2 * q]); }
    bf16_t* hn = (bf16_t*)(p.ws + O_HN) + (size_t)t * 1024 + 16 * lane;
    *(u32x4*)hn = w0; *(u32x4*)(hn + 8) = w1;
}

struct S5Coef { cf2 a; cf2 bbar[16]; };
DI void s5_coefs(const Params& p, int l, int dir, int g, int lane, S5Coef& c) {
    const size_t gi = ((size_t)l * 2 + dir) * 64 + g;
    const float step = expf(p.in[I_SLS][gi]);
    const float lr = p.in[I_SLR][gi * 64 + lane], lim = p.in[I_SLI][gi * 64 + lane];
    const float ar = lr * step, ai = lim * step;
    float sn, cs; sincosf(ai, &sn, &cs);
    const float ea = expf(ar);
    c.a = mk2(ea * cs, ea * sn);
    const float sh = sinf(0.5f * ai);
    const float nr = expm1f(ar) * cs - 2.0f * sh * sh, ni = ea * sn;
    const float inv = 1.0f / (lr * lr + lim * lim);
    const cf2 coef = mk2((nr * lr + ni * lim) * inv, (ni * lr - nr * lim) * inv);
    const float* br = p.in[I_SBR] + (gi * 64 + lane) * 16; const float* bi = p.in[I_SBI] + (gi * 64 + lane) * 16;
#pragma unroll
    for (int q = 0; q < 4; ++q) { const f32x4 r4 = *(const f32x4*)(br + 4 * q), i4 = *(const f32x4*)(bi + 4 * q);
#pragma unroll
        for (int e = 0; e < 4; ++e) c.bbar[4 * q + e] = cmul(coef, mk2(r4[e], i4[e])); }
}
DI void s5_prep_item(const Params& p, int item, LAS unsigned char* lds, int tid) {
    __syncthreads();
    const int l = item >> 6, g = item & 63;
    LAS cf2* Bb = (LAS cf2*)lds;
    LAS cf2* Cc = Bb + 2048;
    LAS cf2* Aa = Cc + 2048;
    LAS float* Kl = (LAS float*)(Aa + 128);
    if (tid < 128) { const int d = tid >> 6, pp = tid & 63; S5Coef cf; s5_coefs(p, l, d, g, pp, cf); Aa[tid] = cf.a;
#pragma unroll
        for (int m = 0; m < 16; ++m) Bb[tid * 16 + m] = cf.bbar[m]; }
#pragma unroll
    for (int i = 0; i < 4; ++i) { const int idx = tid + 512 * i, d = idx >> 10; const size_t gi = ((size_t)l * 2 + d) * 64 + g;
        Cc[idx] = mk2(p.in[I_SCR][gi * 1024 + (idx & 1023)], p.in[I_SCI][gi * 1024 + (idx & 1023)]); }
    __syncthreads();
    {
        const int d = tid >> 8, n = (tid >> 4) & 15, m = tid & 15;
        float Ka[16];
#pragma unroll
        for (int j = 0; j < 16; ++j) Ka[j] = 0.f;
        for (int pp = 0; pp < 64; ++pp) { cf2 z = cmul(Cc[(d * 16 + n) * 64 + pp], Bb[(d * 64 + pp) * 16 + m]); const cf2 a = Aa[d * 64 + pp];
#pragma unroll
            for (int j = 0; j < 16; ++j) { Ka[j] += z.x; z = cmul(z, a); } }
#pragma unroll
        for (int j = 0; j < 16; ++j) Kl[((d * 16 + j) * 16 + n) * 16 + m] = Ka[j];
    }
    __syncthreads();
    bf16_t* W = (bf16_t*)(p.ws + O_S5W) + ((size_t)l * 64 + g) * 256 * 512;
    bf16_t* E = (bf16_t*)(p.ws + O_S5E) + ((size_t)l * 64 + g) * 256 * 256;
    const float* skip = p.in[I_SSK] + l * 1024 + 16 * g;
#pragma unroll 1
    for (int i = 0; i < 64; ++i) { const int idx = tid + 512 * i, row = idx >> 7, k = (idx & 127) * 2, sr = row >> 4, n = row & 15, s2 = k >> 4, m = k & 15;
        float v0 = 0.f, v1 = 0.f;
        if (s2 <= sr) { v0 += Kl[((sr - s2) * 16 + n) * 16 + m]; v1 += Kl[((sr - s2) * 16 + n) * 16 + m + 1]; }
        if (s2 >= sr) { v0 += Kl[((16 + s2 - sr) * 16 + n) * 16 + m]; v1 += Kl[((16 + s2 - sr) * 16 + n) * 16 + m + 1]; }
        if (s2 == sr) { if (m == n) v0 += skip[n]; if (m + 1 == n) v1 += skip[n]; }
        *(unsigned*)(W + (size_t)row * 512 + k) = pk_bf16(v0, v1); }
#pragma unroll 1
    for (int i = 0; i < 4; ++i) { const int idx = tid + 512 * i, d = idx >> 10, n = (idx >> 6) & 15, pp = idx & 63;
        const cf2 a = Aa[d * 64 + pp]; cf2 z = cmul(Cc[(d * 16 + n) * 64 + pp], a);
#pragma unroll 1
        for (int e = 1; e <= 16; ++e) { const int sr = d == 0 ? e - 1 : 16 - e; bf16_t* w = W + (size_t)(sr * 16 + n) * 512 + 256 + d * 128 + pp;
            w[0] = (bf16_t)(pk_bf16(z.x, 0.f) & 0xffffu); w[64] = (bf16_t)(pk_bf16(-z.y, 0.f) & 0xffffu); z = cmul(z, a); } }
#pragma unroll 1
    for (int i = 0; i < 4; ++i) { const int idx = tid + 512 * i, d = idx >> 10, pp = (idx >> 4) & 63, m = idx & 15;
        const cf2 a = Aa[d * 64 + pp]; cf2 z = Bb[(d * 64 + pp) * 16 + m];
#pragma unroll 1
        for (int e = 0; e < 16; ++e) { const int s2 = d == 0 ? 15 - e : e; bf16_t* w = E + (size_t)(d * 128 + pp) * 256 + s2 * 16 + m;
            w[0] = (bf16_t)(pk_bf16(z.x, 0.f) & 0xffffu); w[(size_t)64 * 256] = (bf16_t)(pk_bf16(z.y, 0.f) & 0xffffu); z = cmul(z, a); } }
    __syncthreads();
}
template <int MODE>
DI void s5_mm(const Params& p, int l, int item, int tid) {
    constexpr int K = MODE ? 512 : 256;
    const int g = item >> 3, bt = item & 7, wid = __builtin_amdgcn_readfirstlane(tid >> 6), lane = tid & 63, fr = lane & 15, fq = lane >> 4;
    const int b0 = 64 * bt;
    const bf16_t* Ua = (const bf16_t*)(p.ws + O_SU) + ((size_t)g * 512 + b0 + fr) * 256 + 8 * fq;
    const bf16_t* Xa = (const bf16_t*)(p.ws + O_XIN) + ((size_t)g * 512 + b0 + fr) * 256 + 8 * fq;
    const bf16_t* Bw = (MODE ? (const bf16_t*)(p.ws + O_S5W) + ((size_t)l * 64 + g) * 256 * 512 : (const bf16_t*)(p.ws + O_S5E) + ((size_t)l * 64 + g) * 256 * 256) + (size_t)(32 * wid + fr) * K + 8 * fq;
    f32x4 acc[4][2];
#pragma unroll
    for (int r = 0; r < 4; ++r) { acc[r][0] = (f32x4){0.f, 0.f, 0.f, 0.f}; acc[r][1] = (f32x4){0.f, 0.f, 0.f, 0.f}; }
#pragma unroll 4
    for (int ks = 0; ks < K / 32; ++ks) {
        const bf16_t* ap = (ks < 8) ? Ua + 32 * ks : Xa + 32 * (ks - 8);
        const bf16x8 w0 = *(const bf16x8*)(Bw + 32 * ks), w1 = *(const bf16x8*)(Bw + (size_t)16 * K + 32 * ks);
#pragma unroll
        for (int r = 0; r < 4; ++r) { const bf16x8 af = *(const bf16x8*)(ap + (size_t)(16 * r) * 256);
            acc[r][0] = __builtin_amdgcn_mfma_f32_16x16x32_bf16(w0, af, acc[r][0], 0, 0, 0);
            acc[r][1] = __builtin_amdgcn_mfma_f32_16x16x32_bf16(w1, af, acc[r][1], 0, 0, 0); }
    }
    if (MODE == 0) {
#pragma unroll
        for (int r = 0; r < 4; ++r) { float* xe = (float*)(p.ws + O_XE) + ((size_t)g * 512 + b0 + 16 * r + fr) * 256 + 32 * wid + 4 * fq;
            *(f32x4*)xe = acc[r][0]; *(f32x4*)(xe + 16) = acc[r][1]; }
    } else {
#pragma unroll
        for (int r = 0; r < 4; ++r) { bf16_t* ys = (bf16_t*)(p.ws + O_YS) + (size_t)(16 * (b0 + 16 * r + fr) + 2 * wid) * 1024 + 16 * g + 4 * fq;
            *(u32x2*)ys = (u32x2){pk_bf16(acc[r][0][0], acc[r][0][1]), pk_bf16(acc[r][0][2], acc[r][0][3])};
            *(u32x2*)(ys + 1024) = (u32x2){pk_bf16(acc[r][1][0], acc[r][1][1]), pk_bf16(acc[r][1][2], acc[r][1][3])}; }
    }
}
DI void s5_scan(const Params& p, int l, int idx) {
    const int g = idx >> 7, d = (idx >> 6) & 1, pp = idx & 63;
    const size_t gi = ((size_t)l * 2 + d) * 64 + g;
    const float step = expf(p.in[I_SLS][gi]);
    const float ar = p.in[I_SLR][gi * 64 + pp] * step, ai = p.in[I_SLI][gi * 64 + pp] * step;
    float sn, cs; sincosf(ai, &sn, &cs); const float ea = expf(ar);
    cf2 a = mk2(ea * cs, ea * sn);
#pragma unroll
    for (int i = 0; i < 4; ++i) a = cmul(a, a);
    const float* __restrict__ xe = (const float*)(p.ws + O_XE) + (size_t)g * 512 * 256 + d * 128 + pp;
    bf16_t* __restrict__ xi = (bf16_t*)(p.ws + O_XIN) + (size_t)g * 512 * 256 + d * 128 + pp;
    cf2 X = mk2(0.f, 0.f);
#pragma unroll 1
    for (int i0 = 0; i0 < 512; i0 += 64) {
        float er[64], ei[64];
#pragma unroll
        for (int k = 0; k < 64; ++k) { const int b = d ? 511 - (i0 + k) : i0 + k; er[k] = xe[(size_t)b * 256]; ei[k] = xe[(size_t)b * 256 + 64]; }
#pragma unroll
        for (int k = 0; k < 64; ++k) { const int b = d ? 511 - (i0 + k) : i0 + k;
            xi[(size_t)b * 256] = (bf16_t)(pk_bf16(X.x, 0.f) & 0xffffu); xi[(size_t)b * 256 + 64] = (bf16_t)(pk_bf16(X.y, 0.f) & 0xffffu);
            X = cmul(a, X); X.x += er[k]; X.y += ei[k]; }
    }
}

template <int W>
DI void ln_store(float (&v)[32], const float* __restrict__ gam, const float* __restrict__ bet, float* dstf, bf16_t* dstb, int lane) {
    float s = 0.f;
#pragma unroll
    for (int i = 0; i < 32; ++i) s += v[i];
    const float mu = wave_sum(s) * (1.0f / 2048.0f);
    float q = 0.f;
#pragma unroll
    for (int i = 0; i < 32; ++i) { v[i] -= mu; q += v[i] * v[i]; }
    const float rstd = rsqrtf(wave_sum(q) * (1.0f / 2048.0f) + LN_EPS);
#pragma unroll
    for (int c = 0; c < 32 / W; ++c)
#pragma unroll
        for (int h = 0; h < W / 8; ++h) { const int o = 64 * W * c + W * lane + 8 * h, vi = W * c + 8 * h;
            const f32x4 g0 = *(const f32x4*)(gam + o), g1 = *(const f32x4*)(gam + o + 4), b0 = *(const f32x4*)(bet + o), b1 = *(const f32x4*)(bet + o + 4);
            f32x4 r0, r1;
#pragma unroll
            for (int e = 0; e < 4; ++e) { r0[e] = v[vi + e] * rstd * g0[e] + b0[e]; r1[e] = v[vi + 4 + e] * rstd * g1[e] + b1[e]; }
            *(f32x4*)(dstf + o) = r0; *(f32x4*)(dstf + o + 4) = r1;
            if (dstb) *(u32x4*)(dstb + o) = (u32x4){pk_bf16(r0[0], r0[1]), pk_bf16(r0[2], r0[3]), pk_bf16(r1[0], r1[1]), pk_bf16(r1[2], r1[3])}; }
}
template <int W>
DI void load_row32(const float* __restrict__ src, float (&v)[32], int lane) {
#pragma unroll
    for (int c = 0; c < 32 / W; ++c)
#pragma unroll
        for (int h = 0; h < W / 4; ++h) { const f32x4 a = *(const f32x4*)(src + 64 * W * c + W * lane + 4 * h);
#pragma unroll
            for (int e = 0; e < 4; ++e) v[W * c + 4 * h + e] = a[e]; }
}

constexpr int PB = 8;
DI void load_ln_row16(const float* __restrict__ src, const float* __restrict__ gam, const float* __restrict__ bet, float (&v)[32], int lane) {
    load_row32<16>(src, v, lane);
    float s = 0.f;
#pragma unroll
    for (int i = 0; i < 32; ++i) s += v[i];
    const float mu = wave_sum(s) * (1.0f / 2048.0f);
    float q = 0.f;
#pragma unroll
    for (int i = 0; i < 32; ++i) { v[i] -= mu; q += v[i] * v[i]; }
    const float rstd = rsqrtf(wave_sum(q) * (1.0f / 2048.0f) + LN_EPS);
#pragma unroll
    for (int c = 0; c < 2; ++c)
#pragma unroll
        for (int h = 0; h < 4; ++h) { const int o = 1024 * c + 16 * lane + 4 * h; const f32x4 g = *(const f32x4*)(gam + o), b = *(const f32x4*)(bet + o);
#pragma unroll
            for (int e = 0; e < 4; ++e) v[16 * c + 4 * h + e] = v[16 * c + 4 * h + e] * rstd * g[e] + b[e]; }
}
DI unsigned f2ord(float f) { const unsigned u = __float_as_uint(f); return (u & 0x80000000u) ? ~u : (u | 0x80000000u); }
DI float ord2f(unsigned k) { const unsigned u = (k & 0x80000000u) ? (k & 0x7fffffffu) : ~k; return __uint_as_float(u); }
#define INS16(L, key) do { unsigned k_ = (key); _Pragma("unroll") for (int q_ = 0; q_ < 16; ++q_) { const unsigned mx_ = max(L[q_], k_); k_ = min(L[q_], k_); L[q_] = mx_; } } while (0)
#define CE16(A, a, b) do { const unsigned hi_ = max(A[a], A[b]), lo_ = min(A[a], A[b]); A[a] = hi_; A[b] = lo_; } while (0);
#define SORT16_DESC(N) do { CE16(N,0,1) CE16(N,2,3) CE16(N,4,5) CE16(N,6,7) CE16(N,8,9) CE16(N,10,11) CE16(N,12,13) CE16(N,14,15) CE16(N,0,2) CE16(N,1,3) CE16(N,4,6) CE16(N,5,7) CE16(N,8,10) CE16(N,9,11) CE16(N,12,14) CE16(N,13,15) CE16(N,1,2) CE16(N,5,6) CE16(N,9,10) CE16(N,13,14) CE16(N,0,4) CE16(N,1,5) CE16(N,2,6) CE16(N,3,7) CE16(N,8,12) CE16(N,9,13) CE16(N,10,14) CE16(N,11,15) CE16(N,2,4) CE16(N,3,5) CE16(N,10,12) CE16(N,11,13) CE16(N,1,2) CE16(N,3,4) CE16(N,5,6) CE16(N,9,10) CE16(N,11,12) CE16(N,13,14) CE16(N,0,8) CE16(N,1,9) CE16(N,2,10) CE16(N,3,11) CE16(N,4,12) CE16(N,5,13) CE16(N,6,14) CE16(N,7,15) CE16(N,4,8) CE16(N,5,9) CE16(N,6,10) CE16(N,7,11) CE16(N,2,4) CE16(N,3,5) CE16(N,6,8) CE16(N,7,9) CE16(N,10,12) CE16(N,11,13) CE16(N,1,2) CE16(N,3,4) CE16(N,5,6) CE16(N,7,8) CE16(N,9,10) CE16(N,11,12) CE16(N,13,14) } while (0)
DI float gelu_tanh(float x) { const float z = 0.7978845608028654f * (x + 0.044715f * x * x * x); const float th = 1.0f - 2.0f / (__expf(2.0f * z) + 1.0f); return 0.5f * x * (1.0f + th); }
DI void peer_item(const Params& p, int l, int item, const float* __restrict__ gam, const float* __restrict__ bet, float* outf, bf16_t* outb, LAS unsigned char* lds, int tid_in) {
    __syncthreads();
    int tid = tid_in; asm volatile("" : "+v"(tid));
    const int t0 = item * 32, wid = __builtin_amdgcn_readfirstlane(tid >> 6), lane = tid & 63;
    LAS unsigned* TK = (LAS unsigned*)lds;
    LAS unsigned* EXI = TK + 32 * 16 * 16;
    LAS float* EXG = (LAS float*)(EXI + 32 * 128);
    LAS float* CO = EXG + 32 * 128 + wid * 128;
    {
        const int tl = tid & 31, hc = tid >> 5;
        const bf16_t* sc = (const bf16_t*)(p.ws + O_SCT) + (size_t)(hc * 128) * SCT_LD + t0 + tl;
        unsigned L[16];
#pragma unroll
        for (int q = 0; q < 16; ++q) L[q] = 0u;
        unsigned R[16];
#pragma unroll
        for (int q = 0; q < 16; ++q) R[q] = (unsigned)sc[(size_t)q * SCT_LD];
#pragma unroll 1
        for (int kb = 0; kb < 128; kb += 16) {
            unsigned N[16];
#pragma unroll
            for (int q = 0; q < 16; ++q) { const float v = __uint_as_float(R[q] << 16); N[q] = (f2ord(v) & ~127u) | (unsigned)(127 - kb - q); }
            if (kb < 112) {
#pragma unroll
                for (int q = 0; q < 16; ++q) R[q] = (unsigned)sc[(size_t)(kb + 16 + q) * SCT_LD];
            }
            SORT16_DESC(N);
#pragma unroll
            for (int q = 0; q < 16; ++q) L[q] = max(L[q], N[15 - q]);
#pragma unroll
            for (int k = 8; k >= 1; k >>= 1)
#pragma unroll
                for (int q = 0; q < 16; ++q) if ((q & k) == 0) CE16(L, q, q + k);
        }
#pragma unroll
        for (int q = 0; q < 16; ++q) TK[(tl * 16 + hc) * 16 + q] = L[q];
    }
    __syncthreads();
    if (tid < 256) {
        const int tl = tid & 31, h = tid >> 5;
        LAS unsigned* A = TK + (tl * 16 + 2 * h) * 16; LAS unsigned* B = A + 16;
        float fa[16], fb[16];
#pragma unroll
        for (int i = 0; i < 16; ++i) { fa[i] = ord2f(A[i] & ~127u); fb[i] = ord2f(B[i] & ~127u); }
        unsigned W[16];
#pragma unroll
        for (int q = 0; q < 16; ++q) W[q] = 0u;
#pragma unroll
        for (int i = 0; i < 16; ++i)
#pragma unroll
            for (int j = 0; j < 16; ++j) if ((i + 1) * (j + 1) <= 16) INS16(W, (f2ord(fa[i] + fb[j]) & ~255u) | (unsigned)(255 - (i * 16 + j)));
        const float vmax = ord2f(W[0] & ~255u);
        float ex[16], sum = 0.f;
#pragma unroll
        for (int r = 0; r < 16; ++r) { ex[r] = __expf(ord2f(W[r] & ~255u) - vmax); sum += ex[r]; }
        const float rs = 1.0f / sum;
#pragma unroll
        for (int r = 0; r < 16; ++r) { const unsigned c = 255u - (W[r] & 255u); const unsigned i1 = 127u - (A[c >> 4] & 127u), i2 = 127u - (B[c & 15u] & 127u);
            EXI[tl * 128 + h * 16 + r] = i1 * 128u + i2; EXG[tl * 128 + h * 16 + r] = ex[r] * rs; }
    }
    __syncthreads();
    const unsigned char* U8 = p.ws + O_U16; const unsigned char* V8 = p.ws + O_V16;
    const float* US = (const float*)(p.ws + O_U16 + (size_t)16384 * 2048); const float* VS = (const float*)(p.ws + O_V16 + (size_t)16384 * 2048);
#pragma unroll 1
    for (int ti = 0; ti < 4; ++ti) {
        const int tl = 4 * wid + ti, t = t0 + tl;
        if (ti) __syncthreads();
        int ln = lane; asm volatile("" : "+v"(ln));
        {
            const unsigned id0 = EXI[tl * 128 + ln], id1 = EXI[tl * 128 + 64 + ln]; const float g0 = EXG[tl * 128 + ln], g1 = EXG[tl * 128 + 64 + ln];
            int r0 = 0, r1 = 0;
#pragma unroll 8
            for (int j = 0; j < 128; ++j) { const unsigned o = EXI[tl * 128 + j];
                r0 += (o < id0 || (o == id0 && j < ln)) ? 1 : 0; r1 += (o < id1 || (o == id1 && j < ln + 64)) ? 1 : 0; }
            __builtin_amdgcn_wave_barrier();
            EXI[tl * 128 + r0] = id0; EXG[tl * 128 + r0] = g0; EXI[tl * 128 + r1] = id1; EXG[tl * 128 + r1] = g1;
            __builtin_amdgcn_wave_barrier();
        }
        f32x2 xp[16];
        {
            float xf[32]; load_ln_row16((const float*)(p.ws + O_Y1) + (size_t)t * DM, p.in[I_L1G] + l * DM, p.in[I_L1B] + l * DM, xf, ln);
#pragma unroll
            for (int i = 0; i < 16; ++i) { xp[i].x = xf[2 * i]; xp[i].y = xf[2 * i + 1]; }
            const int eo = ((ln >> 5) & 1) * 4 + ((ln >> 4) & 1) * 2 + ((ln >> 3) & 1);
#pragma unroll 1
            for (int e0 = 0; e0 < 128; e0 += 8) {
                u32x4 ur[8][2];
#pragma unroll
                for (int k = 0; k < 8; ++k) { const unsigned id = EXI[tl * 128 + e0 + k]; const unsigned char* row = U8 + (size_t)id * 2048 + 16 * ln;
                    ur[k][0] = *(const u32x4*)row; ur[k][1] = *(const u32x4*)(row + 1024); }
                const unsigned ido = EXI[tl * 128 + e0 + eo]; const float sco = US[ido], gto = EXG[tl * 128 + e0 + eo];
                float d[8];
#pragma unroll
                for (int k = 0; k < 8; ++k) { f32x2 s2 = (f32x2){0.f, 0.f};
#pragma unroll
                    for (int c = 0; c < 2; ++c)
#pragma unroll
                        for (int e = 0; e < 4; ++e) { const f32x2 lo = __builtin_amdgcn_cvt_pk_f32_fp8(ur[k][c][e], false), hi = __builtin_amdgcn_cvt_pk_f32_fp8(ur[k][c][e], true);
                            s2 += lo * xp[8 * c + 2 * e]; s2 += hi * xp[8 * c + 2 * e + 1]; }
                    d[k] = s2.x + s2.y; }
                float q4[4], q2[2];
#pragma unroll
                for (int k = 0; k < 4; ++k) { const float snd = (ln & 32) ? d[k] : d[k + 4], kp = (ln & 32) ? d[k + 4] : d[k]; q4[k] = kp + __shfl_xor(snd, 32); }
#pragma unroll
                for (int k = 0; k < 2; ++k) { const float snd = (ln & 16) ? q4[k] : q4[k + 2], kp = (ln & 16) ? q4[k + 2] : q4[k]; q2[k] = kp + __shfl_xor(snd, 16); }
                float v = ((ln & 8) ? q2[1] : q2[0]) + __shfl_xor((ln & 8) ? q2[0] : q2[1], 8);
                v += __shfl_xor(v, 4); v += __shfl_xor(v, 2); v += __shfl_xor(v, 1);
                if ((ln & 7) == 0) CO[e0 + eo] = gelu_tanh(v * sco) * gto;
            }
#pragma unroll
            for (int i = 0; i < 16; ++i) { xp[i] = xp[i] * ALPHA; asm volatile("" : "+v"(xp[i])); }
        }
        __syncthreads();
#pragma unroll 1
        for (int e0 = 0; e0 < 128; e0 += PB) {
            u32x4 vr[PB][2]; float cf[PB];
#pragma unroll
            for (int k = 0; k < PB; ++k) { const unsigned id = EXI[tl * 128 + e0 + k]; const unsigned char* row = V8 + (size_t)id * 2048 + 16 * ln;
                vr[k][0] = *(const u32x4*)row; vr[k][1] = *(const u32x4*)(row + 1024); cf[k] = VS[id] * CO[e0 + k]; }
#pragma unroll
            for (int k = 0; k < PB; ++k)
#pragma unroll
                for (int c = 0; c < 2; ++c)
#pragma unroll
                    for (int e = 0; e < 4; ++e) { const f32x2 lo = __builtin_amdgcn_cvt_pk_f32_fp8(vr[k][c][e], false), hi = __builtin_amdgcn_cvt_pk_f32_fp8(vr[k][c][e], true);
                        const f32x2 c2 = (f32x2){cf[k], cf[k]}; xp[8 * c + 2 * e] += c2 * lo; xp[8 * c + 2 * e + 1] += c2 * hi; }
        }
        float acc[32];
#pragma unroll
        for (int i = 0; i < 16; ++i) { acc[2 * i] = xp[i].x; acc[2 * i + 1] = xp[i].y; }
        ln_store<16>(acc, gam, bet, outf + (size_t)t * DM, outb ? outb + (size_t)t * DM : nullptr, ln);
        __builtin_amdgcn_wave_barrier();
    }
    __syncthreads();
}

DI void peer_row_fp8_cvt(float (&v)[32], unsigned char* __restrict__ dst, float* __restrict__ inv_scale, int row, int lane) {
    float m = 0.f;
#pragma unroll
    for (int i = 0; i < 32; ++i) m = fmaxf(m, fabsf(v[i]));
    m = wave_max(m);
    int ex = 0; if (m > 0.f) ex = (int)floorf(log2f(448.0f / m));
    ex = ex > 100 ? 100 : (ex < -100 ? -100 : ex);
    float sc = ldexpf(1.0f, ex); if (m * sc > 448.0f) { sc *= 0.5f; ex -= 1; }
#pragma unroll
    for (int c = 0; c < 2; ++c) { u32x4 w;
#pragma unroll
        for (int e = 0; e < 4; ++e) { unsigned x = 0u; x = __builtin_amdgcn_cvt_pk_fp8_f32(v[16 * c + 4 * e] * sc, v[16 * c + 4 * e + 1] * sc, x, false);
            x = __builtin_amdgcn_cvt_pk_fp8_f32(v[16 * c + 4 * e + 2] * sc, v[16 * c + 4 * e + 3] * sc, x, true); w[e] = x; }
        *(u32x4*)(dst + (size_t)row * 2048 + 1024 * c + 16 * lane) = w; }
    if (lane == 0) inv_scale[row] = ldexpf(1.0f, -ex);
}
DI void peer_rows_fp8(const float* __restrict__ src, unsigned char* __restrict__ dst, float* __restrict__ inv_scale, int row0, int lane) {
    float va[32], vb[32];
    load_row32<16>(src + (size_t)row0 * DM, va, lane); load_row32<16>(src + (size_t)(row0 + 1) * DM, vb, lane);
    peer_row_fp8_cvt(va, dst, inv_scale, row0, lane); peer_row_fp8_cvt(vb, dst, inv_scale, row0 + 1, lane);
}

template <int MASK>
DI void prologue_a(LAS unsigned char* lds, const int wid_s_) {
    {
        PHASE_ARGS(p, tid)
        if (MASK & 1) for (int it = bid; it < NL * TC_PER_LAYER; it += G) tconv_dispatch(p, it, (LAS float*)lds, tid);
        if (MASK & 1) for (int i = gtid; i < NL * 16 * 2048; i += gthreads) { const int l = i >> 15, j = (i >> 11) & 15, k = i & 2047; const float wv = p.in[I_WIN][((size_t)l * DM + k) * NIN + 4096 + j]; ((float*)(ws + O_WGT))[i] = wv; ((bf16_t*)(ws + O_WGB))[i] = (bf16_t)(pk_bf16(wv, 0.f) & 0xffffu); }
        if (MASK & 2) for (int it = bid; it < 1024; it += G) ws_item(p, it, tid);
        if (MASK & 4) for (int it = bid; it < NL * 64; it += G) s5_prep_item(p, it, lds, tid);
        if (MASK & 8) for (int it = gwave; it < NL * 8192; it += gwaves) hid2_item(p, it, lane);
        if (MASK & 8) for (int k = gtid; k < FN; k += gthreads) { float s, c; sincospif(-2.0f * (float)k / 16384.0f, &s, &c); ((cf2*)(ws + O_TW))[k] = mk2(c, s); }
        if (MASK & 8) for (int i = gtid; i < T * DM / 8; i += gthreads) { const f32x4 a = *(const f32x4*)(p.in[I_X] + (size_t)i * 8), b = *(const f32x4*)(p.in[I_X] + (size_t)i * 8 + 4);
            *(u32x4*)((bf16_t*)(ws + O_XB) + (size_t)i * 8) = (u32x4){pk_bf16(a[0], a[1]), pk_bf16(a[2], a[3]), pk_bf16(b[0], b[1]), pk_bf16(b[2], b[3])}; }
    }
}

template <int l>
DI void layer_body(LAS unsigned char* lds, const int wid_s_) {
#pragma unroll 1
        for (int rep_ = 0; rep_ < R_INP; ++rep_)
        {
        {
            PHASE_ARGS(p, tid)
            pg8::StaticOrder S1; S1.init(T, 10240, G, bid);
            pg8::gemm_phase(lds, pg8::Gemm{(const bf16_t*)(ws + O_XB), (const bf16_t*)(ws + O_WIN1) + (size_t)l * 10240 * 2048, T, 10240, 2048}, S1,
                            pg8::EpiIn1{(bf16_t*)(ws + O_Q), (bf16_t*)(ws + O_K), (bf16_t*)(ws + O_O), (bf16_t*)(ws + O_G), (bf16_t*)(ws + O_SU)}, tid);
        }
        {
            PHASE_ARGS(p, tid)
            pg8::StaticOrder S2; S2.init(4096, T, G, bid);
            pg8::gemm_phase(lds, pg8::Gemm{(const bf16_t*)(ws + O_WIN2) + (size_t)l * 4096 * 2048, (const bf16_t*)(ws + O_XB), 4096, T, 2048}, S2,
                            pg8::EpiIn2{(bf16_t*)(ws + O_VT), (bf16_t*)(ws + O_HPT)}, tid);
        }
        {
            PHASE_ARGS(p, tid)
            __syncthreads();
            LAS float* part = (LAS float*)lds;
            const int fr = lane & 15, fq = lane >> 4, tile = 2 * bid + (wid >> 2), kq = wid & 3;
            if (tile < T / 16) {
                const bf16_t* xa = (const bf16_t*)(ws + O_XB) + (size_t)(16 * tile + fr) * DM + 512 * kq + 8 * fq;
                const bf16_t* wb = (const bf16_t*)(ws + O_WGB) + ((size_t)l * 16 + fr) * 2048 + 512 * kq + 8 * fq;
                f32x4 acc = (f32x4){0.f, 0.f, 0.f, 0.f};
#pragma unroll
                for (int ks = 0; ks < 16; ++ks) acc = __builtin_amdgcn_mfma_f32_16x16x32_bf16(*(const bf16x8*)(xa + 32 * ks), *(const bf16x8*)(wb + 32 * ks), acc, 0, 0, 0);
#pragma unroll
                for (int j = 0; j < 4; ++j) part[(wid * 16 + 4 * fq + j) * 16 + fr] = acc[j];
            }
            __syncthreads();
            if (kq == 0 && tile < T / 16) {
#pragma unroll
                for (int j = 0; j < 4; ++j) { const int o = ((4 * fq + j) * 16 + fr); const int w0 = wid * 256;
                    ((float*)(ws + O_MG))[(size_t)(16 * tile + 4 * fq + j) * 16 + fr] = (part[w0 + o] + part[w0 + 256 + o]) + (part[w0 + 512 + o] + part[w0 + 768 + o]); }
            }
            __syncthreads();
        }
        }
        GRID_BARRIER();
#pragma unroll 1
        for (int rep_ = 0; rep_ < R_LOC; ++rep_)
        {
#pragma unroll 1
        for (int r2_ = 0; r2_ < R_LA; ++r2_)
        { PHASE_ARGS(p, tid) for (int it = bid; it < 512; it += G) mlstm_passA(p, l, it, lds, tid); }
#pragma unroll 1
        for (int r2_ = 0; r2_ < R_LH; ++r2_)
        { PHASE_ARGS(p, tid) for (int it = bid; it < 512; it += G) hyena_item(p, l, it, lds, tid); }
#pragma unroll 1
        for (int r2_ = 0; r2_ < R_LS; ++r2_)
        { PHASE_ARGS(p, tid) for (int it = bid; it < 512; it += G) s5_mm<0>(p, l, it, tid); }
        }
        GRID_BARRIER();
#pragma unroll 1
        for (int rep_ = 0; rep_ < R_SCAN; ++rep_)
        {
            PHASE_ARGS(p, tid)
            for (int it = bid; it < 2048; it += G) yh_transpose_item(p, it, lds, tid);
            mlstm_passB(p, gtid, gthreads, bid, tid);
            const float* pu = p.in[I_PU] + (size_t)l * 16384 * DM; const float* pv = p.in[I_PV] + (size_t)l * 16384 * DM;
            for (int bb = bid; bb < 256; bb += G) {
                if (wid == 0) { if (lane < 32) s5_scan(p, l, bb * 32 + lane); }
                else for (int r2 = bb * 64 + wid - 1; r2 < bb * 64 + 64; r2 += 7) {
                    if (r2 < 8192) peer_rows_fp8(pu, ws + O_U16, (float*)(ws + O_U16 + (size_t)16384 * 2048), 2 * r2, lane);
                    else peer_rows_fp8(pv, ws + O_V16, (float*)(ws + O_V16 + (size_t)16384 * 2048), 2 * (r2 - 8192), lane);
                }
            }
        }
        GRID_BARRIER();
#pragma unroll 1
        for (int rep_ = 0; rep_ < R_OUT; ++rep_)
        {
#pragma unroll 1
        for (int r2_ = 0; r2_ < R_OM; ++r2_)
        { PHASE_ARGS(p, tid) for (int it = bid; it < 512; it += G) mlstm_passC(p, l, it, lds, tid); }
#pragma unroll 1
        for (int r2_ = 0; r2_ < R_OS; ++r2_)
        { PHASE_ARGS(p, tid) for (int it = bid; it < 512; it += G) s5_mm<1>(p, l, it, tid); }
        }
        GRID_BARRIER();
#pragma unroll 1
        for (int rep_ = 0; rep_ < R_FIN; ++rep_)
        { PHASE_ARGS(p, tid) for (int t = gwave; t < T; t += gwaves) mlstm_final(p, l, t, lane); }
        GRID_BARRIER();
        {
            PHASE_ARGS(p, tid)
            pg8::BranchOrder Sb; Sb.base.init(T, 2048, G, bid);
            Sb.A0 = (const bf16_t*)(ws + O_HN); Sb.A1 = (const bf16_t*)(ws + O_YH); Sb.A2 = (const bf16_t*)(ws + O_YS);
            Sb.B0 = (const bf16_t*)(ws + O_WA) + (size_t)l * 2048 * 1024; Sb.B1 = (const bf16_t*)(ws + O_WB) + (size_t)l * 2048 * 1024; Sb.B2 = (const bf16_t*)(ws + O_WC) + (size_t)l * 4096 * 1024;
            pg8::gemm_phase(lds, pg8::Gemm{Sb.A0, Sb.B0, T, 2048, 1024}, Sb,
                            pg8::EpiBranchAll{(const bf16_t*)(ws + O_G), (bf16_t*)(ws + O_MRG), (bf16_t*)(ws + O_MRG) + (size_t)T * DM, (bf16_t*)(ws + O_MRGB)}, tid);
        }
        GRID_BARRIER();
#pragma unroll 1
        for (int rep_ = 0; rep_ < R_WOUT; ++rep_)
        {
            PHASE_ARGS(p, tid)
            const float* xcur = l == 0 ? p.in[I_X] : (const float*)(ws + O_XF);
            pg8::StaticOrder So; So.init(T, 2048, G, bid);
            pg8::gemm_phase(lds, pg8::Gemm{(const bf16_t*)(ws + O_MRGB), (const bf16_t*)(ws + O_WO) + (size_t)l * 2048 * 2048, T, 2048, 2048}, So, pg8::EpiWout{xcur, (float*)(ws + O_Y1), (bf16_t*)(ws + O_Y1B), (float*)(ws + O_STAT)}, tid);
        }
        GRID_BARRIER();
#pragma unroll 1
        for (int rep_ = 0; rep_ < R_SC; ++rep_)
        {
            PHASE_ARGS(p, tid)
            pg8::StaticOrder Ss; Ss.init(2048, T, G, bid);
            LAS float* MS = (LAS float*)(lds + 131072);
            { pg8::Unit u0; __syncthreads();
              if (Ss.next(0, u0) && tid < 256) { const float* st = (const float*)(ws + O_STAT) + (size_t)(u0.pn * 256 + tid) * 64; float s1 = 0.f, s2 = 0.f;
#pragma unroll
                  for (int i = 0; i < 16; ++i) { const f32x4 v = *(const f32x4*)(st + 4 * i); s1 += v[0] + v[2]; s2 += v[1] + v[3]; }
                  const float mu = s1 * (1.0f / 2048.0f), var = fmaxf(s2 * (1.0f / 2048.0f) - mu * mu, 0.f);
                  MS[2 * tid] = mu; MS[2 * tid + 1] = rsqrtf(var + LN_EPS); }
              __syncthreads(); }
            pg8::gemm_phase(lds, pg8::Gemm{(const bf16_t*)(ws + O_WS) + (size_t)l * 2048 * 2048, (const bf16_t*)(ws + O_Y1B), 2048, T, 2048}, Ss,
                            pg8::EpiScore{(bf16_t*)(ws + O_SCT), (const float*)(ws + O_C1) + l * 2048, (const float*)(ws + O_C2) + l * 2048, MS}, tid);
        }
        GRID_BARRIER();
#pragma unroll 1
        for (int rep_ = 0; rep_ < R_PEER; ++rep_)
        {
            PHASE_ARGS(p, tid)
            float* outf = l == NL - 1 ? p.out : (float*)(ws + O_XF); bf16_t* outb = l == NL - 1 ? nullptr : (bf16_t*)(ws + O_XB);
            for (int it = bid; it < T / 32; it += G) peer_item(p, l, it, p.in[I_L2G] + l * DM, p.in[I_L2B] + l * DM, outf, outb, lds, tid);
        }
        if (l < NL - 1) GRID_BARRIER();
    }

__global__ void __launch_bounds__(512, 2) mega(Params p_unused) {
    extern __shared__ __attribute__((aligned(16))) unsigned char smem[];
    LAS unsigned char* lds = (LAS unsigned char*)smem;
    const int wid_s_ = __builtin_amdgcn_readfirstlane((int)threadIdx.x >> 6);
    {
        volatile LAS unsigned* xbw = (volatile LAS unsigned*)(lds + LDS_BYTES - 16);
        if (threadIdx.x == 0) { xbw[0] = 0u; xbw[1] = 0u; xbw[2] = 0u; xbw[3] = 0u; }
        __syncthreads();
        PHASE_ARGS(p, tid) xcd_barrier_post((unsigned*)(p.ws + O_BAR));
    }

    prologue_a<15>(lds, wid_s_);
#ifdef PRO_DUP_MASK
    prologue_a<PRO_DUP_MASK>(lds, wid_s_);
#endif
    GRID_BARRIER();
    {
        PHASE_ARGS(p, tid)
        for (int it = bid; it < NL * 64; it += G) ftap_item(p, it, tid);
    }
    {
        PHASE_ARGS(p, tid)
        for (int i = gtid; i < NL * 2048; i += gthreads) {
            const float* a1 = (const float*)(ws + O_C1P) + (size_t)i * 128; const float* a2 = (const float*)(ws + O_C2P) + (size_t)i * 128; float s1 = 0.f, s2 = 0.f;
#pragma unroll 4
            for (int k = 0; k < 32; ++k) { const f32x4 u = *(const f32x4*)(a1 + 4 * k), v = *(const f32x4*)(a2 + 4 * k); s1 += (u[0] + u[1]) + (u[2] + u[3]); s2 += (v[0] + v[1]) + (v[2] + v[3]); }
            ((float*)(ws + O_C1))[i] = s1; ((float*)(ws + O_C2))[i] = s2; }
    }
    GRID_BARRIER();
#pragma unroll 1
    for (int rep_ = 0; rep_ < R_PROB; ++rep_)
    {
        PHASE_ARGS(p, tid)
        for (int it = bid; it < NL * 512; it += G) filt_item(p, it, lds, tid);
    }
    GRID_BARRIER();

    layer_body<0>(lds, wid_s_);
    layer_body<1>(lds, wid_s_);
    layer_body<2>(lds, wid_s_);
    layer_body<3>(lds, wid_s_);
}

extern "C" void kernel_launch(void* const* d_in, const int* in_sizes, int n_in, void* d_out, int out_size, void* d_ws, size_t ws_size, hipStream_t stream) {
    static int grid = 0;
    if (!grid) {
        int dev = 0, cus = 0, per_cu = 0;
        hipGetDevice(&dev);
        hipDeviceGetAttribute(&cus, hipDeviceAttributeMultiprocessorCount, dev);
        hipFuncSetAttribute((const void*)mega, hipFuncAttributeMaxDynamicSharedMemorySize, LDS_BYTES);
        hipOccupancyMaxActiveBlocksPerMultiprocessor(&per_cu, mega, NTHREADS, LDS_BYTES);
        if (per_cu < 1) { fprintf(stderr, "mega: occupancy query says 0 blocks per CU\n"); per_cu = 1; }
        grid = cus;
    }
    if (ws_size < WS_NEED || n_in < 34) { fprintf(stderr, "kernel_launch: workspace too small (%zu < %zu) or inputs missing\n", ws_size, (size_t)WS_NEED); return; }
    hipMemsetAsync((unsigned char*)d_ws + O_BAR, 0, 16384, stream);
    Params p{};
    for (int i = 0; i < 34; ++i) p.in[i] = (const float*)d_in[i];
    p.out = (float*)d_out; p.ws = (unsigned char*)d_ws;
    hipLaunchKernelGGL(mega, dim3(grid), dim3(NTHREADS), LDS_BYTES, stream, p);
}
```

```cpp
#include <hip/hip_runtime.h>
#include <stdint.h>
#include <stdio.h>

#define DI __device__ __forceinline__
#define LAS __attribute__((address_space(3)))
typedef unsigned short bf16_t;
typedef short bf16x8 __attribute__((ext_vector_type(8)));
typedef float f32x4 __attribute__((ext_vector_type(4)));
typedef float f32x2 __attribute__((ext_vector_type(2)));
typedef f32x2 cf2;
__device__ __forceinline__ cf2 mk2(float a, float b) { cf2 r; r.x = a; r.y = b; return r; }
typedef unsigned u32x4 __attribute__((ext_vector_type(4)));
typedef unsigned u32x2 __attribute__((ext_vector_type(2)));

constexpr int T = 8192, DM = 2048, BW = 1024, NL = 4, NIN = 14352;
constexpr float ALPHA = 1.6817928305074290f;
constexpr float LN_EPS = 1e-5f;
constexpr int NTHREADS = 512;
constexpr int LDS_BYTES = 153600;

constexpr size_t al256(size_t x) { return (x + 255) & ~(size_t)255; }
constexpr size_t O_BAR  = 0;
constexpr size_t O_TW   = 16384;
constexpr size_t O_WIN1 = O_TW + 131072;
constexpr size_t O_WIN2 = O_WIN1 + (size_t)NL * 10240 * 2048 * 2;
constexpr size_t O_WGT  = O_WIN2 + (size_t)NL * 4096 * 2048 * 2;
constexpr size_t O_WA   = O_WGT + (size_t)NL * 16 * 2048 * 4;
constexpr size_t O_WB   = O_WA + (size_t)NL * 2048 * 1024 * 2;
constexpr size_t O_WC   = O_WB + (size_t)NL * 2048 * 1024 * 2;
constexpr size_t O_WO   = O_WC + (size_t)NL * 4096 * 1024 * 2;
constexpr size_t O_WS   = O_WO + (size_t)NL * 2048 * 2048 * 2;
constexpr size_t O_U16  = O_WS + (size_t)NL * 2048 * 2048 * 2;
constexpr size_t O_V16  = O_U16 + (size_t)16384 * 2048 * 2;
constexpr size_t O_HID2 = O_V16 + (size_t)16384 * 2048 * 2;
constexpr int PM_STRIDE = 8200;
constexpr size_t O_PM   = O_HID2 + (size_t)NL * 8192 * 64 * 4;
constexpr size_t O_XB   = O_PM + (size_t)NL * 512 * PM_STRIDE * 16;
constexpr size_t O_XF   = O_XB + (size_t)T * DM * 2;
constexpr size_t O_Q    = O_XF + (size_t)T * DM * 4;
constexpr size_t O_FT   = O_Q;
constexpr size_t O_K    = O_Q + (size_t)T * 1024 * 2;
constexpr size_t O_O    = O_K + (size_t)T * 1024 * 2;
constexpr size_t O_SU   = O_O + (size_t)T * 1024 * 2;
constexpr size_t O_G    = O_SU + (size_t)T * 1024 * 4;
constexpr size_t O_KT   = O_G + (size_t)T * 6144 * 2;
constexpr size_t O_VT   = O_KT + (size_t)1024 * T * 2;
constexpr size_t O_HPT  = O_VT + (size_t)1024 * T * 2;
constexpr size_t O_SCT  = O_HPT;
constexpr int SCT_LD = T + 64;
constexpr size_t O_MG   = O_HPT + (size_t)3072 * T * 4;
constexpr size_t O_KV   = O_MG + (size_t)T * 16 * 4;
constexpr size_t O_MRG  = O_KV;
constexpr size_t O_YSD  = O_KV;
constexpr size_t O_Y1   = O_KV + (size_t)T * DM * 4;
constexpr size_t O_NLOC = O_KV + (size_t)512 * 65536 * 4;
constexpr size_t O_MLOC = O_NLOC + (size_t)512 * 256 * 4;
constexpr size_t O_BLAST= O_MLOC + 4096;
constexpr size_t O_CST  = O_BLAST + 4096;
constexpr size_t O_NST  = O_CST + (size_t)512 * 65536 * 2;
constexpr size_t O_MST  = O_NST + (size_t)512 * 256 * 4;
constexpr size_t O_HDIR = O_MST + 4096;
constexpr size_t O_HN   = O_HDIR + (size_t)2 * T * 1024 * 4;
constexpr size_t O_YH   = O_HN + (size_t)T * 1024 * 2;
constexpr size_t O_YS   = O_YH + (size_t)T * 1024 * 2;
constexpr size_t O_S5W  = O_YS + (size_t)T * 1024 * 2;
constexpr size_t O_S5E  = O_S5W + (size_t)NL * 64 * 256 * 512 * 2;
constexpr size_t O_XE   = O_S5E + (size_t)NL * 64 * 256 * 256 * 2;
constexpr size_t O_XIN  = O_XE + (size_t)64 * 512 * 256 * 4;
constexpr size_t O_MRGB = O_XIN + (size_t)64 * 512 * 256 * 2;
constexpr size_t O_X1F  = O_MRGB + (size_t)T * DM * 2;
constexpr size_t O_X1B  = O_X1F + (size_t)T * DM * 4;
constexpr size_t WS_NEED = O_X1B + (size_t)T * DM * 2;
constexpr size_t O_Y1B  = O_X1B;
constexpr size_t O_STAT = O_X1F;
constexpr size_t O_C1P  = O_X1F + ((size_t)4 << 20);
constexpr size_t O_C2P  = O_X1F + ((size_t)8 << 20);
constexpr size_t O_C1   = O_X1F + ((size_t)12 << 20);
constexpr size_t O_C2   = O_C1 + 65536;
constexpr size_t O_WGB  = O_X1F + ((size_t)13 << 20);
static_assert(WS_NEED < ((size_t)1 << 31), "workspace too large");
static_assert(O_MG - O_Q >= (size_t)NL * 2048 * 8192 * 4, "filter-tap alias does not fit");

#ifndef R_PROA
#define R_PROA 1
#endif
#ifndef R_PROB
#define R_PROB 1
#endif
#ifndef R_INP
#define R_INP 1
#endif
#ifndef R_LOC
#define R_LOC 1
#endif
#ifndef R_LA
#define R_LA 1
#endif
#ifndef R_LH
#define R_LH 1
#endif
#ifndef R_LS
#define R_LS 1
#endif
#ifndef R_OM
#define R_OM 1
#endif
#ifndef R_OS
#define R_OS 1
#endif
#ifndef R_SCAN
#define R_SCAN 1
#endif
#ifndef R_OUT
#define R_OUT 1
#endif
#ifndef R_FIN
#define R_FIN 1
#endif
#ifndef R_BR
#define R_BR 1
#endif
#ifndef R_WOUT
#define R_WOUT 1
#endif
#ifndef R_LN1
#define R_LN1 1
#endif
#ifndef R_SC
#define R_SC 1
#endif
#ifndef R_PEER
#define R_PEER 1
#endif
struct Params { const float* in[34]; float* out; unsigned char* ws; };
typedef const __attribute__((address_space(4))) Params* KParams;
#define PHASE_ARGS(q, tid) Params q; { KParams kp_ = (KParams)__builtin_amdgcn_kernarg_segment_ptr(); asm volatile("" : "+s"(kp_)); \
    _Pragma("unroll") for (int i_ = 0; i_ < 34; ++i_) q.in[i_] = kp_->in[i_]; q.out = kp_->out; q.ws = kp_->ws; } \
    int wid = wid_s_; asm volatile("" : "+s"(wid)); int lane; asm volatile("v_mbcnt_lo_u32_b32 %0, -1, 0\n\tv_mbcnt_hi_u32_b32 %0, -1, %0" : "=v"(lane)); const int tid = wid * 64 + lane; (void)wid; (void)lane; \
    const int bid = blockIdx.x, G = gridDim.x; const int gtid = bid * NTHREADS + tid, gthreads = G * NTHREADS, gwave = bid * 8 + wid, gwaves = G * 8; \
    (void)gtid; (void)gthreads; (void)gwave; (void)gwaves; unsigned char* ws = q.ws; (void)ws;
enum { I_X = 0, I_WIN, I_MGB, I_MNG, I_WMO, I_HCW, I_HCB, I_HW1, I_HB1, I_HW2, I_HB2, I_HFQ, I_HW3, I_HDC, I_HSK, I_WHO,
       I_SLR, I_SLI, I_SLS, I_SBR, I_SBI, I_SCR, I_SCI, I_SSK, I_WSG, I_WOUT, I_L1G, I_L1B, I_PWQ, I_PSK, I_PU, I_PV, I_L2G, I_L2B };

typedef __bf16 bf16x2v __attribute__((ext_vector_type(2)));
DI unsigned pk_bf16(float lo, float hi) { f32x2 v; v.x = lo; v.y = hi; return __builtin_bit_cast(unsigned, __builtin_convertvector(v, bf16x2v)); }
DI float bf_lo(unsigned w) { return __uint_as_float(w << 16); }
DI float bf_hi(unsigned w) { return __uint_as_float(w & 0xffff0000u); }
DI float sigmoidf_(float x) { return __builtin_amdgcn_rcpf(1.0f + __expf(-x)); }
DI float wave_sum(float v) { for (int o = 32; o > 0; o >>= 1) v += __shfl_xor(v, o); return v; }
DI float wave_max(float v) { for (int o = 32; o > 0; o >>= 1) v = fmaxf(v, __shfl_xor(v, o)); return v; }
DI float wave_scan_add(float v, int lane) { for (int o = 1; o < 64; o <<= 1) { float t = __shfl_up(v, o); if (lane >= o) v += t; } return v; }
DI float wave_scan_max(float v, int lane) { for (int o = 1; o < 64; o <<= 1) { float t = __shfl_up(v, o); if (lane >= o) v = fmaxf(v, t); } return v; }
DI cf2 cmul(cf2 a, cf2 b) { return mk2(a.x * b.x - a.y * b.y, a.x * b.y + a.y * b.x); }
DI cf2 cmulc(cf2 a, cf2 b) { return mk2(a.x * b.x + a.y * b.y, a.y * b.x - a.x * b.y); }

#define XB_TMO      128
#define XB_XCNT(j)  (256  + 64 * (j))
#define XB_XSUB(j)  (1280 + 64 * (j))
#define XB_XGEN(j)  (2304 + 64 * (j))
#define XB_TOP      3328
#define XB_TOPGEN   3392
#define XCD_BAR_WORDS 3456
#define XB_SPIN_CAP (1u << 22)
DI unsigned xb_ld(unsigned* p)              { return __hip_atomic_load(p, __ATOMIC_RELAXED, __HIP_MEMORY_SCOPE_AGENT); }
DI unsigned xb_add(unsigned* p, unsigned v) { return __hip_atomic_fetch_add(p, v, __ATOMIC_RELAXED, __HIP_MEMORY_SCOPE_AGENT); }
DI unsigned xb_xcc_id() { return (unsigned)__builtin_amdgcn_s_getreg((3 << 11) | 20) & 0xFu; }
#define XB_SPIN(cond, bar) do { unsigned _sp = 0; while (cond) { __builtin_amdgcn_s_sleep(1); \
    if ((++_sp & 255u) == 0u) { if (xb_ld(&(bar)[XB_TMO])) break; if (_sp > XB_SPIN_CAP) { atomicAdd(&(bar)[XB_TMO], 1u); break; } } } } while (0)
DI void xcd_barrier_complete(unsigned* bar, unsigned x, unsigned& nloc, unsigned& nx) {
    const unsigned G = gridDim.x * gridDim.y * gridDim.z;
    unsigned sum, cnt, mine, sp = 0u;
    for (;;) {
        sum = 0u; cnt = 0u; mine = 0u;
#pragma unroll
        for (unsigned j = 0; j < 16; ++j) { const unsigned c = xb_ld(&bar[XB_XCNT(j)]); sum += c; cnt += (c > 0u) ? 1u : 0u; mine = (j == x) ? c : mine; }
        if (sum == G) break;
        __builtin_amdgcn_s_sleep(1);
        if ((++sp & 255u) == 0u) { if (xb_ld(&bar[XB_TMO])) break; if (sp > XB_SPIN_CAP) { atomicAdd(&bar[XB_TMO], 1u); break; } }
    }
    nloc = mine > 0u ? mine : 1u; nx = cnt > 0u ? cnt : 1u;
}
DI void xcd_barrier_post(unsigned* bar) { if (threadIdx.x == 0) (void)xb_add(&bar[XB_XCNT(xb_xcc_id())], 1u); }
DI void xcd_barrier(unsigned* bar_in, volatile LAS unsigned* st, const bool is_t0) {
    asm volatile("s_waitcnt vmcnt(0)" ::: "memory");
    __syncthreads();
    if (is_t0) {
        unsigned* bar = bar_in; asm volatile("" : "+s"(bar));
        const unsigned x = xb_xcc_id();
        __builtin_amdgcn_s_waitcnt(0);
        unsigned nloc = st[0], nx = st[1];
        if (nloc == 0u) { xcd_barrier_complete(bar, x, nloc, nx); st[0] = nloc; st[1] = nx; }
        const unsigned old = xb_add(&bar[XB_XSUB(x)], 1u);
        const unsigned gen = old / nloc;
        if (old + 1u == (gen + 1u) * nloc) {
            __builtin_amdgcn_fence(__ATOMIC_RELEASE, "agent");
            asm volatile("s_waitcnt vmcnt(0)" ::: "memory");
            const unsigned og = xb_add(&bar[XB_TOP], 1u);
            const unsigned tg = og / nx;
            if (og + 1u == (tg + 1u) * nx) xb_add(&bar[XB_TOPGEN], 1u);
            else XB_SPIN(xb_ld(&bar[XB_TOPGEN]) == tg, bar);
            __builtin_amdgcn_fence(__ATOMIC_ACQUIRE, "agent");
            xb_add(&bar[XB_XGEN(x)], 1u);
            asm volatile("s_waitcnt vmcnt(0)" ::: "memory");
        } else {
            XB_SPIN(xb_ld(&bar[XB_XGEN(x)]) == gen, bar);
            __builtin_amdgcn_fence(__ATOMIC_ACQUIRE, "agent");
            asm volatile("s_waitcnt vmcnt(0)" ::: "memory");
        }
    }
    __syncthreads();
}
#define GRID_BARRIER() do { KParams kb_ = (KParams)__builtin_amdgcn_kernarg_segment_ptr(); asm volatile("" : "+s"(kb_)); \
    xcd_barrier((unsigned*)(kb_->ws + O_BAR), (volatile LAS unsigned*)(lds + LDS_BYTES - 16), wid_s_ == 0 && __builtin_amdgcn_mbcnt_hi(~0u, __builtin_amdgcn_mbcnt_lo(~0u, 0u)) == 0u); } while (0)

namespace pg8 {
constexpr int BM = 256, BK = 64, HALF = 128, HTB = HALF * BK * 2, STAGE_BYTES = 8 * HTB, NXCD = 8, WGM = 8;
DI int lds_byte(int r, int c) { const int st = (r >> 4) * 2 + (c >> 5), rr = r & 15, cc = c & 31, ob = rr * 64 + cc * 2; return st * 1024 + (ob ^ (((ob >> 9) & 1) << 5)); }
DI void stage_rc(int b, int& R, int& C) { const int st = b / 1024, sb = b % 1024, swz = sb ^ (((sb >> 9) & 1) << 5); R = (st >> 1) * 16 + swz / 64; C = (st & 1) * 32 + (swz % 64) / 2; }
DI int perm32(int rho) { const int n = rho >> 4, i = rho & 15; return 8 * (i >> 2) + 4 * n + (i & 3); }
struct Unit { int pm, pn, which; };
struct Gemm { const bf16_t* A; const bf16_t* Bt; int M, N, K; };
struct StaticOrder {
    int nM, nN, nwg, G, c;
    DI void init(int M, int N, int G_, int c_) { nM = M / BM; nN = N / BM; nwg = nM * nN; G = G_; c = c_; }
    DI bool next(int i, Unit& u) const {
        const long L = (long)i * G + c; if (L >= nwg) return false;
        int wgid = (int)L; { const int q = nwg / NXCD, r = nwg % NXCD, xcd = wgid % NXCD, off = wgid / NXCD; wgid = (xcd < r ? xcd * (q + 1) : r * (q + 1) + (xcd - r) * q) + off; }
        const int nig = WGM * nN, gid = wgid / nig, fm = gid * WGM, gsz = (nM - fm) < WGM ? (nM - fm) : WGM;
        u.pm = fm + ((wgid % nig) % gsz); u.pn = (wgid % nig) / gsz; u.which = 0; return true;
    }
    DI void a_ready(const Unit&) const {}
    DI void done(const Unit&) const {}
    DI const char* a_base(const Gemm& g, const Unit& u, size_t tstep) const { return (const char*)g.A + (size_t)u.pm * tstep; }
    DI const char* b_base(const Gemm& g, const Unit& u, size_t tstep) const { return (const char*)g.Bt + (size_t)u.pn * tstep; }
};
struct BranchOrder {
    StaticOrder base; const bf16_t *A0, *A1, *A2, *B0, *B1, *B2;
    DI bool next(int i, Unit& u) const { Unit b; if (i > 3 || !base.next(0, b)) return false; u.pm = b.pm; u.which = i; u.pn = i < 2 ? b.pn : 2 * b.pn + (i - 2); return true; }
    DI void a_ready(const Unit&) const {}
    DI void done(const Unit&) const {}
    DI const char* a_base(const Gemm&, const Unit& u, size_t tstep) const { const bf16_t *a0 = A0, *a1 = A1, *a2 = A2; asm volatile("" : "+s"(a0), "+s"(a1), "+s"(a2));
        return (const char*)(u.which == 0 ? a0 : (u.which == 1 ? a1 : a2)) + (size_t)u.pm * tstep; }
    DI const char* b_base(const Gemm&, const Unit& u, size_t tstep) const { const bf16_t *b0 = B0, *b1 = B1, *b2 = B2; asm volatile("" : "+s"(b0), "+s"(b1), "+s"(b2));
        return (const char*)(u.which == 0 ? b0 : (u.which == 1 ? b1 : b2)) + (size_t)u.pn * tstep; }
};

template <class Epi, class Sched>
DI void gemm_phase(LAS unsigned char* lds, const Gemm g, const Sched& S, const Epi& E, const int tid) {
    const int wid = __builtin_amdgcn_readfirstlane(tid >> 6), lane = tid & 63, wr = wid >> 2, wc = wid & 3, fr = lane & 15, fq = lane >> 4;
    const int K = g.K, nt = K / BK;
    unsigned voffA[2], voffB[2];
#pragma unroll
    for (int i = 0; i < 2; ++i) { int R, C; stage_rc(tid * 16 + i * 8192, R, C); const int Rb = Epi::PERM ? ((R & ~31) + perm32(R & 31)) : R;
        voffA[i] = (unsigned)(R * K + C) * 2u; voffB[i] = (unsigned)(Rb * K + C) * 2u; }
    const size_t kstep = (size_t)(BK * 2);
    const size_t hstep = (size_t)HALF * K * 2;
    const size_t tstep = 2 * hstep;
    const unsigned ldsw = (unsigned)wid * 1024u;
    const int aoff = lds_byte(wr * 64 + fr, fq * 8), boff = lds_byte(wc * 32 + fr, fq * 8);
#define PG8_SA(b, h) (((b) * 2 + (h)) * HTB)
#define PG8_SB(b, h) ((4 + (b) * 2 + (h)) * HTB)
#define PG8_STAGE(bufoff, gbase, voff) do { _Pragma("unroll") for (int _i = 0; _i < 2; ++_i) \
        __builtin_amdgcn_global_load_lds((const unsigned*)((const char*)(gbase) + (voff)[_i]), (LAS unsigned*)(lds + (bufoff) + ldsw + _i * 8192), 16, 0, 0); } while (0)
#define PG8_LDA(dst, b, h) do { _Pragma("unroll") for (int m = 0; m < 4; ++m) _Pragma("unroll") for (int k = 0; k < 2; ++k) dst[m][k] = *(const LAS bf16x8*)(lds + PG8_SA(b, h) + aoff + m * 2048 + k * 1024); } while (0)
#define PG8_LDB(dst, b, h) do { _Pragma("unroll") for (int n = 0; n < 2; ++n) _Pragma("unroll") for (int k = 0; k < 2; ++k) dst[n][k] = *(const LAS bf16x8*)(lds + PG8_SB(b, h) + boff + n * 2048 + k * 1024); } while (0)
#define PG8_MMA(ai, bj, At, Bt) do { __builtin_amdgcn_s_setprio(1); _Pragma("unroll") for (int m = 0; m < 4; ++m) _Pragma("unroll") for (int n = 0; n < 2; ++n) _Pragma("unroll") for (int k = 0; k < 2; ++k) \
        acc[ai][bj][m][n] = __builtin_amdgcn_mfma_f32_16x16x32_bf16(Bt[n][k], At[m][k], acc[ai][bj][m][n], 0, 0, 0); __builtin_amdgcn_s_setprio(0); } while (0)
#define PG8_WAIT_V(n) asm volatile("s_waitcnt vmcnt(" #n ")" ::: "memory")
#define PG8_WAIT_L(n) asm volatile("s_waitcnt lgkmcnt(" #n ")" ::: "memory")
#define PG8_BAR __builtin_amdgcn_s_barrier()
#define PG8_SCHED __builtin_amdgcn_sched_barrier(0)
    Unit cur, nxt; int ui = 0;
    if (!S.next(0, cur)) return;
    f32x4 acc[2][2][4][2];
#pragma unroll
    for (int a = 0; a < 2; ++a)
#pragma unroll
        for (int b = 0; b < 2; ++b)
#pragma unroll
            for (int m = 0; m < 4; ++m)
#pragma unroll
                for (int n = 0; n < 2; ++n) acc[a][b][m][n] = (f32x4){0.f, 0.f, 0.f, 0.f};
    bf16x8 At[4][2], B0[2][2], B1[2][2];
    const char* cA = S.a_base(g, cur, tstep); const char* cB = S.b_base(g, cur, tstep);
    S.a_ready(cur);
    PG8_STAGE(PG8_SB(0, 0), cB, voffB); PG8_STAGE(PG8_SA(0, 0), cA, voffA); PG8_STAGE(PG8_SB(0, 1), cB + hstep, voffB); PG8_STAGE(PG8_SA(0, 1), cA + hstep, voffA);
    if (wr == 1) PG8_BAR;
    PG8_WAIT_V(4); PG8_BAR;
    PG8_STAGE(PG8_SB(1, 0), cB + kstep, voffB); PG8_STAGE(PG8_SA(1, 0), cA + kstep, voffA); PG8_STAGE(PG8_SB(1, 1), cB + hstep + kstep, voffB);
    PG8_WAIT_V(6); PG8_BAR;
    for (;;) {
        const bool has_next = S.next(ui + 1, nxt);
        const char* nA = has_next ? S.a_base(g, nxt, tstep) : cA; const char* nB = has_next ? S.b_base(g, nxt, tstep) : cB;
        for (int t = 0; t < nt; t += 2) {
            const bool last = (t == nt - 2);
            const char* a1 = cA + (size_t)(t + 1) * kstep;
            const char* a2 = last ? nA : cA + (size_t)(t + 2) * kstep; const char* b2 = last ? nB : cB + (size_t)(t + 2) * kstep;
            const char* a3 = a2 + kstep; const char* b3 = b2 + kstep;
            if (last && has_next) S.a_ready(nxt);
            PG8_LDB(B0, 0, 0); PG8_SCHED; PG8_LDA(At, 0, 0); PG8_STAGE(PG8_SA(1, 1), a1 + hstep, voffA);
            PG8_WAIT_L(8); PG8_BAR; PG8_WAIT_L(0); PG8_MMA(0, 0, At, B0); PG8_BAR; PG8_SCHED;
            PG8_LDB(B1, 0, 1); PG8_STAGE(PG8_SB(0, 0), b2, voffB);
            PG8_BAR; PG8_WAIT_L(0); PG8_MMA(0, 1, At, B1); PG8_BAR;
            PG8_LDA(At, 0, 1); PG8_STAGE(PG8_SA(0, 0), a2, voffA);
            PG8_BAR; PG8_WAIT_L(0); PG8_MMA(1, 0, At, B0); PG8_BAR; PG8_SCHED;
            PG8_STAGE(PG8_SB(0, 1), b2 + hstep, voffB);
            PG8_WAIT_V(6); PG8_BAR; PG8_MMA(1, 1, At, B1); PG8_BAR;
            PG8_LDB(B0, 1, 0); PG8_SCHED; PG8_LDA(At, 1, 0); PG8_STAGE(PG8_SA(0, 1), a2 + hstep, voffA);
            PG8_WAIT_L(8); PG8_BAR; PG8_WAIT_L(0); PG8_MMA(0, 0, At, B0); PG8_BAR; PG8_SCHED;
            PG8_LDB(B1, 1, 1); PG8_STAGE(PG8_SB(1, 0), b3, voffB);
            PG8_BAR; PG8_WAIT_L(0); PG8_MMA(0, 1, At, B1); PG8_BAR;
            PG8_LDA(At, 1, 1); PG8_STAGE(PG8_SA(1, 0), a3, voffA);
            PG8_BAR; PG8_WAIT_L(0); PG8_MMA(1, 0, At, B0); PG8_BAR; PG8_SCHED;
            PG8_STAGE(PG8_SB(1, 1), b3 + hstep, voffB);
            PG8_WAIT_V(6); PG8_BAR; PG8_MMA(1, 1, At, B1); PG8_BAR;
        }
        E(acc, cur, wr, wc, fr, fq);
        if (!has_next) break;
#pragma unroll
        for (int a = 0; a < 2; ++a)
#pragma unroll
            for (int b = 0; b < 2; ++b)
#pragma unroll
                for (int m = 0; m < 4; ++m)
#pragma unroll
                    for (int n = 0; n < 2; ++n) acc[a][b][m][n] = (f32x4){0.f, 0.f, 0.f, 0.f};
        cur = nxt; cA = nA; cB = nB; ++ui;
    }
    PG8_WAIT_V(0);
    if (wr == 0) PG8_BAR;
    PG8_BAR;
#undef PG8_SA
#undef PG8_SB
#undef PG8_STAGE
#undef PG8_LDA
#undef PG8_LDB
#undef PG8_MMA
#undef PG8_WAIT_V
#undef PG8_WAIT_L
#undef PG8_BAR
#undef PG8_SCHED
}

DI u32x4 pack8(const f32x4& a, const f32x4& b) { return (u32x4){pk_bf16(a[0], a[1]), pk_bf16(a[2], a[3]), pk_bf16(b[0], b[1]), pk_bf16(b[2], b[3])}; }
DI f32x4 sig4(const f32x4& a) { return (f32x4){sigmoidf_(a[0]), sigmoidf_(a[1]), sigmoidf_(a[2]), sigmoidf_(a[3])}; }

struct EpiIn1 {
    static constexpr bool PERM = true;
    bf16_t *Q, *K, *O, *G, *SUG;
    DI void operator()(const f32x4 (&acc)[2][2][4][2], const Unit& u, int wr, int wc, int fr, int fq) const {
        const int row0 = u.pm * BM + wr * 64 + fr, colt = u.pn * BM + wc * 32 + 8 * fq;
#pragma unroll
        for (int ai = 0; ai < 2; ++ai)
#pragma unroll
            for (int m = 0; m < 4; ++m) { const size_t row = (size_t)(row0 + ai * HALF + m * 16);
#pragma unroll
                for (int bj = 0; bj < 2; ++bj) { const int c = colt + bj * HALF; const f32x4 v0 = acc[ai][bj][m][0], v1 = acc[ai][bj][m][1];
                    if (u.pn < 4)       *(u32x4*)(Q + row * 1024 + c) = pack8(v0, v1);
                    else if (u.pn < 8)  *(u32x4*)(K + row * 1024 + (c - 1024)) = pack8(v0 * 0.0625f, v1 * 0.0625f);
                    else if (u.pn < 12) *(u32x4*)(O + row * 1024 + (c - 2048)) = pack8(v0, v1);
                    else if (u.pn < 16) { const int ch = c - 3072; *(u32x4*)(SUG + ((size_t)(ch >> 4) * T + row) * 16 + (ch & 15)) = pack8(v0, v1); }
                    else                *(u32x4*)(G + row * 6144 + (c - 4096)) = pack8(sig4(v0), sig4(v1));
                } }
    }
};
struct EpiIn2 {
    static constexpr bool PERM = true;
    bf16_t *VT, *HPT;
    DI void operator()(const f32x4 (&acc)[2][2][4][2], const Unit& u, int wr, int wc, int fr, int fq) const {
        const int row0 = u.pm * BM + wr * 64 + fr, colt = u.pn * BM + wc * 32 + 8 * fq;
#pragma unroll
        for (int ai = 0; ai < 2; ++ai)
#pragma unroll
            for (int m = 0; m < 4; ++m) { const int row = row0 + ai * HALF + m * 16;
#pragma unroll
                for (int bj = 0; bj < 2; ++bj) { const int c = colt + bj * HALF; const f32x4 v0 = acc[ai][bj][m][0], v1 = acc[ai][bj][m][1];
                    if (u.pm < 4) *(u32x4*)(VT + (size_t)row * T + c) = pack8(v0, v1);
                    else *(u32x4*)(HPT + (size_t)(row - 1024) * T + c) = pack8(v0, v1);
                } }
    }
};
struct EpiBranchAll {
    static constexpr bool PERM = true;
    const bf16_t* G; bf16_t *T1, *T2, *MRGB;
    DI void operator()(const f32x4 (&acc)[2][2][4][2], const Unit& u, int wr, int wc, int fr, int fq) const {
        const int row0 = u.pm * BM + wr * 64 + fr;
        if (u.which < 2) {
            const int colt = u.pn * BM + wc * 32 + 8 * fq; bf16_t* Td = u.which ? T2 : T1;
#pragma unroll
            for (int ai = 0; ai < 2; ++ai)
#pragma unroll
                for (int m = 0; m < 4; ++m) { const size_t row = (size_t)(row0 + ai * HALF + m * 16);
#pragma unroll
                    for (int bj = 0; bj < 2; ++bj) { const int c = colt + bj * HALF;
                        const u32x4 gw = *(const u32x4*)(G + row * 6144 + u.which * 2048 + c);
                        const f32x4 g0 = (f32x4){bf_lo(gw[0]), bf_hi(gw[0]), bf_lo(gw[1]), bf_hi(gw[1])}, g1 = (f32x4){bf_lo(gw[2]), bf_hi(gw[2]), bf_lo(gw[3]), bf_hi(gw[3])};
                        *(u32x4*)(Td + row * DM + c) = pack8(g0 * acc[ai][bj][m][0], g1 * acc[ai][bj][m][1]); } }
        } else {
            const int c = u.pn * HALF + wc * 32 + 8 * fq;
#pragma unroll
            for (int ai = 0; ai < 2; ++ai)
#pragma unroll
                for (int m = 0; m < 4; ++m) { const size_t row = (size_t)(row0 + ai * HALF + m * 16);
                    const u32x4 gw = *(const u32x4*)(G + row * 6144 + 2 * 2048 + c), t1 = *(const u32x4*)(T1 + row * DM + c), t2 = *(const u32x4*)(T2 + row * DM + c);
                    const f32x4 g0 = (f32x4){bf_lo(gw[0]), bf_hi(gw[0]), bf_lo(gw[1]), bf_hi(gw[1])}, g1 = (f32x4){bf_lo(gw[2]), bf_hi(gw[2]), bf_lo(gw[3]), bf_hi(gw[3])};
                    const f32x4 s0 = (f32x4){bf_lo(t1[0]) + bf_lo(t2[0]), bf_hi(t1[0]) + bf_hi(t2[0]), bf_lo(t1[1]) + bf_lo(t2[1]), bf_hi(t1[1]) + bf_hi(t2[1])};
                    const f32x4 s1 = (f32x4){bf_lo(t1[2]) + bf_lo(t2[2]), bf_hi(t1[2]) + bf_hi(t2[2]), bf_lo(t1[3]) + bf_lo(t2[3]), bf_hi(t1[3]) + bf_hi(t2[3])};
                    *(u32x4*)(MRGB + row * DM + c) = pack8(s0 + g0 * acc[ai][0][m][0] * sig4(acc[ai][1][m][0]), s1 + g1 * acc[ai][0][m][1] * sig4(acc[ai][1][m][1]));
                }
        }
    }
};
struct EpiWout {
    static constexpr bool PERM = true;
    const float* X; float* Y1; bf16_t* Y1B; float* STAT;
    DI void operator()(const f32x4 (&acc)[2][2][4][2], const Unit& u, int wr, int wc, int fr, int fq) const {
        const int row0 = u.pm * BM + wr * 64 + fr, colt = u.pn * BM + wc * 32 + 8 * fq;
#pragma unroll
        for (int ai = 0; ai < 2; ++ai)
#pragma unroll
            for (int m = 0; m < 4; ++m) { const size_t row = (size_t)(row0 + ai * HALF + m * 16);
                float s1 = 0.f, s2 = 0.f;
#pragma unroll
                for (int bj = 0; bj < 2; ++bj) { const size_t o = row * DM + colt + bj * HALF;
                    const f32x4 y0 = ALPHA * *(const f32x4*)(X + o) + acc[ai][bj][m][0], y1 = ALPHA * *(const f32x4*)(X + o + 4) + acc[ai][bj][m][1];
                    *(f32x4*)(Y1 + o) = y0; *(f32x4*)(Y1 + o + 4) = y1; *(u32x4*)(Y1B + o) = pack8(y0, y1);
#pragma unroll
                    for (int e = 0; e < 4; ++e) { s1 += y0[e] + y1[e]; s2 += y0[e] * y0[e] + y1[e] * y1[e]; } }
                s1 += __shfl_xor(s1, 16); s1 += __shfl_xor(s1, 32); s2 += __shfl_xor(s2, 16); s2 += __shfl_xor(s2, 32);
                if (fq == 0) *(f32x2*)(STAT + (row * 32 + u.pn * 4 + wc) * 2) = (f32x2){s1, s2};
            }
    }
};
struct EpiScore {
    static constexpr bool PERM = true;
    bf16_t* C; const float *C1, *C2; const LAS float* MS;
    DI void operator()(const f32x4 (&acc)[2][2][4][2], const Unit& u, int wr, int wc, int fr, int fq) const {
        const int row0 = u.pm * BM + wr * 64 + fr, tl0 = wc * 32 + 8 * fq, colt = u.pn * BM + tl0;
        f32x4 mu[2][2], rs[2][2];
#pragma unroll
        for (int bj = 0; bj < 2; ++bj)
#pragma unroll
            for (int n = 0; n < 2; ++n)
#pragma unroll
                for (int e = 0; e < 4; ++e) { const int tl = tl0 + bj * HALF + 4 * n + e; mu[bj][n][e] = MS[2 * tl]; rs[bj][n][e] = MS[2 * tl + 1]; }
#pragma unroll
        for (int ai = 0; ai < 2; ++ai)
#pragma unroll
            for (int m = 0; m < 4; ++m) { const size_t row = (size_t)(row0 + ai * HALF + m * 16); const float c1 = C1[row], c2 = C2[row];
#pragma unroll
                for (int bj = 0; bj < 2; ++bj) { bf16_t* d = C + row * SCT_LD + colt + bj * HALF;
                    *(u32x4*)d = pack8(rs[bj][0] * (acc[ai][bj][m][0] - mu[bj][0] * c1) + c2, rs[bj][1] * (acc[ai][bj][m][1] - mu[bj][1] * c1) + c2); } }
    }
};
}

DI void tconv_item(const float* __restrict__ src, size_t ld, int c0, bf16_t* __restrict__ dst, int K, int k0, LAS float* tile, int tid) {
    __syncthreads();
    { float v[32]; const float* sp = src + (size_t)(k0 + (tid >> 6)) * ld + c0 + (tid & 63);
#pragma unroll
      for (int i = 0; i < 32; ++i) v[i] = sp[(size_t)(8 * i) * ld];
#pragma unroll
      for (int i = 0; i < 32; ++i) tile[((tid >> 6) + 8 * i) * 65 + (tid & 63)] = v[i]; }
    __syncthreads();
#pragma unroll
    for (int i = 0; i < 4; ++i) { const int idx = tid + 512 * i, rr = idx >> 5, ks = idx & 31;
        float v[8];
#pragma unroll
        for (int j = 0; j < 8; ++j) v[j] = tile[(ks * 8 + j) * 65 + rr];
        *(u32x4*)(dst + (size_t)rr * K + k0 + ks * 8) = (u32x4){pk_bf16(v[0], v[1]), pk_bf16(v[2], v[3]), pk_bf16(v[4], v[5]), pk_bf16(v[6], v[7])}; }
    __syncthreads();
}
constexpr int TC_PER_LAYER = 2560;
DI void tconv_dispatch(const Params& p, int item, LAS float* tile, int tid) {
    const int l = item / TC_PER_LAYER; int it = item % TC_PER_LAYER;
    unsigned char* ws = p.ws;
    if (it < 1792) {
        const int rt = it >> 3, kt = it & 7; int r0 = rt * 64; const float* src = p.in[I_WIN] + (size_t)l * DM * NIN;
        if (rt < 160) { const int col = r0 < 2048 ? r0 : (r0 < 3072 ? r0 + 1024 : r0 + 4112);
            tconv_item(src, NIN, col, (bf16_t*)(ws + O_WIN1) + ((size_t)l * 10240 + r0) * 2048, 2048, kt * 256, tile, tid); }
        else { r0 -= 10240; const int col = r0 < 1024 ? r0 + 2048 : r0 + 3088;
            tconv_item(src, NIN, col, (bf16_t*)(ws + O_WIN2) + ((size_t)l * 4096 + r0) * 2048, 2048, kt * 256, tile, tid); }
        return;
    }
    it -= 1792;
    if (it < 128) { const int rt = it >> 2, kt = it & 3; tconv_item(p.in[I_WMO] + (size_t)l * BW * DM, DM, rt * 64, (bf16_t*)(ws + O_WA) + ((size_t)l * 2048 + rt * 64) * 1024, 1024, kt * 256, tile, tid); return; }
    it -= 128;
    if (it < 128) { const int rt = it >> 2, kt = it & 3; tconv_item(p.in[I_WHO] + (size_t)l * BW * DM, DM, rt * 64, (bf16_t*)(ws + O_WB) + ((size_t)l * 2048 + rt * 64) * 1024, 1024, kt * 256, tile, tid); return; }
    it -= 128;
    if (it < 256) { const int rt = it >> 2, kt = it & 3, r0 = rt * 64, u = r0 >> 8, w = r0 & 255; const int col = w < 128 ? 128 * u + w : 2048 + 128 * u + (w - 128);
        tconv_item(p.in[I_WSG] + (size_t)l * BW * 4096, 4096, col, (bf16_t*)(ws + O_WC) + ((size_t)l * 4096 + r0) * 1024, 1024, kt * 256, tile, tid); return; }
    it -= 256;
    { const int rt = it >> 3, kt = it & 7; tconv_item(p.in[I_WOUT] + (size_t)l * DM * DM, DM, rt * 64, (bf16_t*)(ws + O_WO) + ((size_t)l * 2048 + rt * 64) * 2048, 2048, kt * 256, tile, tid); }
}
DI bf16x8 ld8_bf16(const float* __restrict__ src) { const f32x4 a = *(const f32x4*)src, b = *(const f32x4*)(src + 4);
    return __builtin_bit_cast(bf16x8, (u32x4){pk_bf16(a[0], a[1]), pk_bf16(a[2], a[3]), pk_bf16(b[0], b[1]), pk_bf16(b[2], b[3])}); }
DI void ws_item(const Params& p, int item, int tid) {
    const int l = item >> 8, hc = (item >> 4) & 15, dt = item & 15;
    const int wid = __builtin_amdgcn_readfirstlane(tid >> 6), lane = tid & 63, fr = lane & 15, fq = lane >> 4;
    const float* sk = p.in[I_PSK] + ((size_t)l * 16 + hc) * 16384 + fr * 128 + 8 * fq;
    const float* wq = p.in[I_PWQ] + (size_t)l * DM * DM + (size_t)(128 * dt + 16 * wid + fr) * DM + hc * 128 + 8 * fq;
    f32x4 acc[8];
#pragma unroll
    for (int m = 0; m < 8; ++m) acc[m] = (f32x4){0.f, 0.f, 0.f, 0.f};
#pragma unroll
    for (int ks = 0; ks < 4; ++ks) { const bf16x8 bfr = ld8_bf16(wq + 32 * ks);
#pragma unroll
        for (int m = 0; m < 8; ++m) acc[m] = __builtin_amdgcn_mfma_f32_16x16x32_bf16(ld8_bf16(sk + (16 * m) * 128 + 32 * ks), bfr, acc[m], 0, 0, 0); }
    const int dcol = 128 * dt + 16 * wid + fr;
    const float gam = p.in[I_L1G][l * DM + dcol], bet = p.in[I_L1B][l * DM + dcol];
    bf16_t* dst = (bf16_t*)(p.ws + O_WS) + ((size_t)l * 2048 + hc * 128 + 4 * fq) * 2048 + dcol;
    float* c1p = (float*)(p.ws + O_C1P) + ((size_t)l * 2048 + hc * 128 + 4 * fq) * 128 + dt * 8 + wid;
    float* c2p = (float*)(p.ws + O_C2P) + ((size_t)l * 2048 + hc * 128 + 4 * fq) * 128 + dt * 8 + wid;
#pragma unroll
    for (int m = 0; m < 8; ++m)
#pragma unroll
        for (int j = 0; j < 4; ++j) { const unsigned wb = pk_bf16(acc[m][j] * gam, 0.f) & 0xffffu;
            dst[(size_t)(16 * m + j) * 2048] = (bf16_t)wb;
            float s1 = __uint_as_float(wb << 16), s2 = acc[m][j] * bet;
            s1 += __shfl_xor(s1, 1); s1 += __shfl_xor(s1, 2); s1 += __shfl_xor(s1, 4); s1 += __shfl_xor(s1, 8);
            s2 += __shfl_xor(s2, 1); s2 += __shfl_xor(s2, 2); s2 += __shfl_xor(s2, 4); s2 += __shfl_xor(s2, 8);
            if (fr == 0) { c1p[(size_t)(16 * m + j) * 128] = s1; c2p[(size_t)(16 * m + j) * 128] = s2; } }
}
DI void hid2_item(const Params& p, int item, int lane) {
    const int l = item >> 13, t = item & 8191;
    const float* w1 = p.in[I_HW1] + (size_t)l * 33 * 64; const float* w2 = p.in[I_HW2] + (size_t)l * 64 * 64;
    float cs = 0.f, sn = 0.f;
    { const int i = lane & 15; const double band = 1e-4 + (double)i * ((15.0 - 1e-4) / 15.0); double r = (double)t * band / 8192.0; r -= floor(r);
      const float fr = (float)r; sincospif(2.0f * fr, &sn, &cs); }
    float acc = p.in[I_HB1][l * 64 + lane] + ((float)t / 8191.0f) * w1[lane];
#pragma unroll
    for (int i = 0; i < 16; ++i) { const float c = __shfl(cs, i), s = __shfl(sn, i); acc += c * w1[(1 + i) * 64 + lane] - s * w1[(17 + i) * 64 + lane]; }
    const float h1 = sinf(p.in[I_HFQ][(l * 2 + 0) * 64 + lane] * acc);
    float acc2 = p.in[I_HB2][l * 64 + lane];
#pragma unroll 16
    for (int i = 0; i < 64; ++i) acc2 += __shfl(h1, i) * w2[i * 64 + lane];
    const float h2 = sinf(p.in[I_HFQ][(l * 2 + 1) * 64 + lane] * acc2);
    const float h2n = __shfl_down(h2, 1);
    if ((lane & 1) == 0) ((unsigned*)(p.ws + O_HID2))[(((size_t)l * 8192 + t) * 64 + lane) >> 1] = pk_bf16(h2, h2n);
}

constexpr int FN = 16384;
DI int rev4_14(int k) { unsigned v = __brev((unsigned)k) >> 18; return (int)(((v & 0x2AAAu) >> 1) | ((v & 0x1555u) << 1)); }
DI int SW(int e) { const int h = e >> 5; return e ^ ((h ^ (h << 1)) & 31); }
struct FftTw { cf2 a0[3], b0[3], sa[3], sb[3], a2[3], b2[3], a4[3], b4[3]; };
DI void fft_load_tw(FftTw& t, const cf2* __restrict__ tw, int tid) {
#pragma unroll
    for (int k = 1; k <= 3; ++k) {
        t.a0[k - 1] = tw[tid * k]; t.b0[k - 1] = tw[4 * tid * k]; t.sa[k - 1] = tw[512 * k]; t.sb[k - 1] = tw[2048 * k];
        const int j2 = tid & 63, j4 = tid & 3;
        t.a2[k - 1] = tw[j2 * 16 * k]; t.b2[k - 1] = tw[j2 * 64 * k]; t.a4[k - 1] = tw[j4 * 256 * k]; t.b4[k - 1] = tw[j4 * 1024 * k];
    }
}
DI cf2 cmulk(cf2 z, float cr, float ci) { return mk2(z.x * cr - z.y * ci, z.x * ci + z.y * cr); }
template <int n, bool CONJ> DI cf2 mulw16(cf2 z) {
    constexpr float C1 = 0.9238795325112867f, S1 = 0.3826834323650898f, H = 0.7071067811865476f;
    constexpr float sg = CONJ ? -1.0f : 1.0f;
    if (n == 1) return cmulk(z, C1, -S1 * sg);
    if (n == 2) return cmulk(z, H, -H * sg);
    if (n == 3) return cmulk(z, S1, -C1 * sg);
    if (n == 4) return CONJ ? mk2(-z.y, z.x) : mk2(z.y, -z.x);
    if (n == 6) return cmulk(z, -H, -H * sg);
    return cmulk(z, -C1, S1 * sg);
}
DI void bfly_f(cf2& x0, cf2& x1, cf2& x2, cf2& x3) {
    const cf2 a0 = x0 + x2, a1 = x0 - x2, a2 = x1 + x3, a3 = x1 - x3;
    x0 = a0 + a2; x2 = a0 - a2; x1 = mk2(a1.x + a3.y, a1.y - a3.x); x3 = mk2(a1.x - a3.y, a1.y + a3.x);
}
DI void bfly_i(cf2& u0, cf2& u1, cf2& u2, cf2& u3) {
    const cf2 b0 = u0 + u2, b1 = u0 - u2, b2 = u1 + u3, b3 = u1 - u3;
    u0 = b0 + b2; u2 = b0 - b2; u1 = mk2(b1.x - b3.y, b1.y + b3.x); u3 = mk2(b1.x + b3.y, b1.y - b3.x);
}
template <int P, bool INV>
DI void fft_pass16(LAS cf2* x, const FftTw& tw, int tid) {
    constexpr int lq1 = 12 - 2 * (P + 1), q1 = 1 << lq1, q0 = 4 * q1;
    cf2 wa[3], wb[3];
#pragma unroll
    for (int k = 0; k < 3; ++k) { wa[k] = P == 0 ? tw.a0[k] : (P == 2 ? tw.a2[k] : tw.a4[k]); wb[k] = P == 0 ? tw.b0[k] : (P == 2 ? tw.b2[k] : tw.b4[k]); }
#pragma unroll 1
    for (int i = 0; i < 2; ++i) {
        const int gp = tid + 512 * i, jp = gp & (q1 - 1), base = ((gp >> lq1) << (lq1 + 4)) + jp;
        cf2 t[4][4];
#pragma unroll
        for (int m1 = 0; m1 < 4; ++m1)
#pragma unroll
            for (int m2 = 0; m2 < 4; ++m2) t[m1][m2] = x[SW(base + m1 * q0 + m2 * q1)];
        if (!INV) {
#pragma unroll
            for (int m2 = 0; m2 < 4; ++m2) { bfly_f(t[0][m2], t[1][m2], t[2][m2], t[3][m2]);
                t[1][m2] = cmul(t[1][m2], wa[0]); t[2][m2] = cmul(t[2][m2], wa[1]); t[3][m2] = cmul(t[3][m2], wa[2]); }
            t[1][1] = mulw16<1, false>(t[1][1]); t[2][1] = mulw16<2, false>(t[2][1]); t[3][1] = mulw16<3, false>(t[3][1]);
            t[1][2] = mulw16<2, false>(t[1][2]); t[2][2] = mulw16<4, false>(t[2][2]); t[3][2] = mulw16<6, false>(t[3][2]);
            t[1][3] = mulw16<3, false>(t[1][3]); t[2][3] = mulw16<6, false>(t[2][3]); t[3][3] = mulw16<9, false>(t[3][3]);
#pragma unroll
            for (int k1 = 0; k1 < 4; ++k1) { bfly_f(t[k1][0], t[k1][1], t[k1][2], t[k1][3]);
                t[k1][1] = cmul(t[k1][1], wb[0]); t[k1][2] = cmul(t[k1][2], wb[1]); t[k1][3] = cmul(t[k1][3], wb[2]); }
        } else {
#pragma unroll
            for (int k1 = 0; k1 < 4; ++k1) { t[k1][1] = cmulc(t[k1][1], wb[0]); t[k1][2] = cmulc(t[k1][2], wb[1]); t[k1][3] = cmulc(t[k1][3], wb[2]);
                bfly_i(t[k1][0], t[k1][1], t[k1][2], t[k1][3]); }
            t[1][1] = mulw16<1, true>(t[1][1]); t[2][1] = mulw16<2, true>(t[2][1]); t[3][1] = mulw16<3, true>(t[3][1]);
            t[1][2] = mulw16<2, true>(t[1][2]); t[2][2] = mulw16<4, true>(t[2][2]); t[3][2] = mulw16<6, true>(t[3][2]);
            t[1][3] = mulw16<3, true>(t[1][3]); t[2][3] = mulw16<6, true>(t[2][3]); t[3][3] = mulw16<9, true>(t[3][3]);
#pragma unroll
            for (int m2 = 0; m2 < 4; ++m2) { t[1][m2] = cmulc(t[1][m2], wa[0]); t[2][m2] = cmulc(t[2][m2], wa[1]); t[3][m2] = cmulc(t[3][m2], wa[2]);
                bfly_i(t[0][m2], t[1][m2], t[2][m2], t[3][m2]); }
        }
#pragma unroll
        for (int m1 = 0; m1 < 4; ++m1)
#pragma unroll
            for (int m2 = 0; m2 < 4; ++m2) x[SW(base + m1 * q0 + m2 * q1)] = t[m1][m2];
        if (P == 0) {
#pragma unroll
            for (int k = 0; k < 3; ++k) { wa[k] = cmul(wa[k], tw.sa[k]); wb[k] = cmul(wb[k], tw.sb[k]); }
        }
    }
    __syncthreads();
}
template <bool INV>
DI void fft_pass4_last(LAS cf2* x, int tid) {
#pragma unroll 4
    for (int i = 0; i < 8; ++i) { const int b4 = 4 * (tid + 512 * i);
        const int e0 = SW(b4), e1 = SW(b4 + 1), e2 = SW(b4 + 2), e3 = SW(b4 + 3);
        cf2 x0 = x[e0], x1 = x[e1], x2 = x[e2], x3 = x[e3];
        if (!INV) bfly_f(x0, x1, x2, x3); else bfly_i(x0, x1, x2, x3);
        x[e0] = x0; x[e1] = x1; x[e2] = x2; x[e3] = x3; }
    __syncthreads();
}
DI void fft_fwd(LAS cf2* x, const FftTw& t, int tid) { fft_pass16<0, false>(x, t, tid); fft_pass16<2, false>(x, t, tid); fft_pass16<4, false>(x, t, tid); fft_pass4_last<false>(x, tid); }
DI void fft_inv(LAS cf2* x, const FftTw& t, int tid) { fft_pass4_last<true>(x, tid); fft_pass16<4, true>(x, t, tid); fft_pass16<2, true>(x, t, tid); fft_pass16<0, true>(x, t, tid); }
DI void ftap_item(const Params& p, int item, int tid) {
    const int l = item >> 6, ct = item & 63, wid = __builtin_amdgcn_readfirstlane(tid >> 6), lane = tid & 63, fr = lane & 15, fq = lane >> 4;
    bf16x8 wh[2][2], wl[2][2];
#pragma unroll
    for (int c2 = 0; c2 < 2; ++c2) { const float* w3 = p.in[I_HW3] + (size_t)l * 64 * 2048 + ct * 32 + 16 * c2 + fr;
#pragma unroll
        for (int ks = 0; ks < 2; ++ks) { float v[8]; u32x4 h, lo;
#pragma unroll
            for (int j = 0; j < 8; ++j) v[j] = w3[(size_t)(32 * ks + 8 * fq + j) * 2048];
#pragma unroll
            for (int e = 0; e < 4; ++e) { h[e] = pk_bf16(v[2 * e], v[2 * e + 1]); lo[e] = pk_bf16(v[2 * e] - bf_lo(h[e]), v[2 * e + 1] - bf_hi(h[e])); }
            wh[c2][ks] = __builtin_bit_cast(bf16x8, h); wl[c2][ks] = __builtin_bit_cast(bf16x8, lo); } }
    const bf16_t* hid = (const bf16_t*)(p.ws + O_HID2) + ((size_t)l * 8192 + 1024 * wid + fr) * 64 + 8 * fq;
    float* ft = (float*)(p.ws + O_FT) + ((size_t)l * 2048 + ct * 32 + fr) * 8192 + 1024 * wid + 4 * fq;
#pragma unroll 4
    for (int i = 0; i < 64; ++i) {
        const bf16x8 a0 = *(const bf16x8*)(hid + (size_t)(16 * i) * 64), a1 = *(const bf16x8*)(hid + (size_t)(16 * i) * 64 + 32);
#pragma unroll
        for (int c2 = 0; c2 < 2; ++c2) { f32x4 acc = (f32x4){0.f, 0.f, 0.f, 0.f};
            acc = __builtin_amdgcn_mfma_f32_16x16x32_bf16(a0, wh[c2][0], acc, 0, 0, 0); acc = __builtin_amdgcn_mfma_f32_16x16x32_bf16(a0, wl[c2][0], acc, 0, 0, 0);
            acc = __builtin_amdgcn_mfma_f32_16x16x32_bf16(a1, wh[c2][1], acc, 0, 0, 0); acc = __builtin_amdgcn_mfma_f32_16x16x32_bf16(a1, wl[c2][1], acc, 0, 0, 0);
            *(f32x4*)(ft + (size_t)(16 * c2) * 8192 + 16 * i) = acc; }
    }
}
DI void filt_item(const Params& p, int item, LAS unsigned char* lds, int tid) {
    __syncthreads();
    const int l = item >> 9, pr = item & 511, c1 = 2 * pr;
    LAS cf2* buf = (LAS cf2*)lds; LAS float* red = (LAS float*)(lds + 131072);
    const cf2* tw = (const cf2*)(p.ws + O_TW);
    FftTw ftw; fft_load_tw(ftw, tw, tid);
    const int q = tid >> 7, tl = tid & 127, wid = __builtin_amdgcn_readfirstlane(tid >> 6);
    const float dec = fabsf(p.in[I_HDC][((size_t)l * 2 + (q >> 1)) * 1024 + c1 + (q & 1)]);
    const float* ftc = (const float*)(p.ws + O_FT) + ((size_t)l * 2048 + (q >> 1) * 1024 + c1 + (q & 1)) * 8192 + 4 * tl;
    float we[4];
#pragma unroll
    for (int e = 0; e < 4; ++e) we[e] = expf(-((float)(4 * tl + e) / 8191.0f) * dec);
    const float wstep = expf(-(512.0f / 8191.0f) * dec);
    float wt = 1.0f, asum = 0.f;
    LAS float* bufs = (LAS float*)buf;
#pragma unroll 4
    for (int i = 0; i < 16; ++i) { const int t0 = 4 * tl + 512 * i; const f32x4 fv = *(const f32x4*)(ftc + 512 * i);
#pragma unroll
        for (int e = 0; e < 4; ++e) { const int t = t0 + e; const float f = fv[e] * (wt * we[e]); asum += fabsf(f);
            if (q < 2) bufs[2 * SW(t) + q] = f; else if (t >= 1) bufs[2 * SW(FN - t) + (q - 2)] = f; }
        wt *= wstep; }
    if (tid == 0) buf[SW(8192)] = mk2(0.f, 0.f);
    { const float sq = wave_sum(asum); if ((tid & 63) == 0) red[wid] = sq; }
    __syncthreads();
    float sc[4];
#pragma unroll
    for (int qq = 0; qq < 4; ++qq) sc[qq] = 1.0f / (red[2 * qq] + red[2 * qq + 1] + 1e-6f);
#pragma unroll 2
    for (int i = 0; i < 32; ++i) { const int n = tid + 512 * i; cf2 v = buf[SW(n)]; if (n < 8192) { v.x *= sc[0]; v.y *= sc[1]; } else { v.x *= sc[2]; v.y *= sc[3]; } buf[SW(n)] = v; }
    __syncthreads();
    fft_fwd(buf, ftw, tid);
    f32x4* pm = (f32x4*)(p.ws + O_PM) + ((size_t)l * 512 + pr) * PM_STRIDE;
    const float inv = 1.0f / (2.0f * 16384.0f);
#pragma unroll 1
    for (int i = 0; i < 17; ++i) { const int k = tid + 512 * i; if (k > 8192) break;
        const cf2 A = buf[SW(rev4_14(k))], B = buf[SW(rev4_14((FN - k) & (FN - 1)))];
        const float h1x = 0.5f * (A.x + B.x), h1y = 0.5f * (A.y - B.y), h2x = 0.5f * (A.y + B.y), h2y = -0.5f * (A.x - B.x);
        pm[k] = (f32x4){(h1x + h2x) * inv, (h1y + h2y) * inv, (h1x - h2x) * inv, (h1y - h2y) * inv}; }
    __syncthreads();
}
DI void conv3x8(const bf16_t* __restrict__ row, int t0, float w0, float w1, float w2, float b, float (&o)[8]) {
    const u32x4 cw = *(const u32x4*)(row + t0);
    float c[10];
    c[0] = t0 > 0 ? __uint_as_float(((unsigned)row[t0 - 1]) << 16) : 0.f;
    c[9] = t0 + 8 < T ? __uint_as_float(((unsigned)row[t0 + 8]) << 16) : 0.f;
#pragma unroll
    for (int e = 0; e < 4; ++e) { c[1 + 2 * e] = bf_lo(cw[e]); c[2 + 2 * e] = bf_hi(cw[e]); }
#pragma unroll
    for (int e = 0; e < 8; ++e) o[e] = w0 * c[e] + w1 * c[e + 1] + w2 * c[e + 2] + b;
}
DI void hyena_item(const Params& p, int l, int pr, LAS unsigned char* lds, int tid) {
    __syncthreads();
    LAS cf2* buf = (LAS cf2*)lds;
    const cf2* tw = (const cf2*)(p.ws + O_TW);
    FftTw ftw; fft_load_tw(ftw, tw, tid);
    const bf16_t* hpt = (const bf16_t*)(p.ws + O_HPT);
    const float* cw = p.in[I_HCW] + (size_t)l * 3 * 3072; const float* cb = p.in[I_HCB] + (size_t)l * 3072;
    const int c1 = 2 * pr;
    float w[6][4];
#pragma unroll
    for (int s = 0; s < 3; ++s)
#pragma unroll
        for (int e = 0; e < 2; ++e) { const int ch = s * 1024 + c1 + e; w[s * 2 + e][0] = cw[ch]; w[s * 2 + e][1] = cw[3072 + ch]; w[s * 2 + e][2] = cw[6144 + ch]; w[s * 2 + e][3] = cb[ch]; }
    const bf16_t* r_x0a = hpt + (size_t)(c1) * T;        const bf16_t* r_x0b = r_x0a + T;
    const bf16_t* r_x1a = hpt + (size_t)(1024 + c1) * T; const bf16_t* r_x1b = r_x1a + T;
    const bf16_t* r_va  = hpt + (size_t)(2048 + c1) * T; const bf16_t* r_vb  = r_va + T;
#pragma unroll 1
    for (int i = 0; i < 2; ++i) { const int t0 = 8 * tid + 4096 * i;
        float xa[8], va[8], xb[8], vb[8];
        conv3x8(r_x1a, t0, w[2][0], w[2][1], w[2][2], w[2][3], xa); conv3x8(r_va, t0, w[4][0], w[4][1], w[4][2], w[4][3], va);
        conv3x8(r_x1b, t0, w[3][0], w[3][1], w[3][2], w[3][3], xb); conv3x8(r_vb, t0, w[5][0], w[5][1], w[5][2], w[5][3], vb);
#pragma unroll
        for (int e = 0; e < 8; ++e) { buf[SW(t0 + e)] = mk2(xa[e] * va[e], xb[e] * vb[e]); buf[SW(t0 + e + 8192)] = mk2(0.f, 0.f); } }
    __syncthreads();
    fft_fwd(buf, ftw, tid);
    const f32x4* pm = (const f32x4*)(p.ws + O_PM) + ((size_t)l * 512 + pr) * PM_STRIDE;
#pragma unroll 4
    for (int i = 0; i < 16; ++i) { const int k = tid + 512 * i;
        const int pk = SW(rev4_14(k)), pnk = SW(rev4_14((FN - k) & (FN - 1)));
        const cf2 A = buf[pk], B = buf[pnk]; const f32x4 PMv = pm[k];
        const cf2 P = mk2(PMv[0], PMv[1]), M = mk2(PMv[2], PMv[3]);
        const cf2 Yk = mk2(A.x * P.x - A.y * P.y + B.x * M.x + B.y * M.y, A.x * P.y + A.y * P.x + B.x * M.y - B.y * M.x);
        const cf2 Yn = mk2(B.x * P.x + B.y * P.y + A.x * M.x - A.y * M.y, B.y * P.x - B.x * P.y - A.x * M.y - A.y * M.x);
        buf[pk] = Yk; if (pnk != pk) buf[pnk] = Yn; }
    if (tid == 0) { const int pk = SW(rev4_14(8192)); const cf2 A = buf[pk]; const f32x4 PMv = pm[8192];
        buf[pk] = mk2(A.x * PMv[0] - A.y * PMv[1] + A.x * PMv[2] + A.y * PMv[3], A.x * PMv[1] + A.y * PMv[0] + A.x * PMv[3] - A.y * PMv[2]); }
    __syncthreads();
    fft_inv(buf, ftw, tid);
    const float ska = p.in[I_HSK][l * 1024 + c1], skb = p.in[I_HSK][l * 1024 + c1 + 1];
    bf16_t* yht = (bf16_t*)(p.ws + O_KT);
#pragma unroll 1
    for (int i = 0; i < 2; ++i) { const int t0 = 8 * tid + 4096 * i;
        float xa[8], va[8], xb[8], vb[8], ga[8], gb[8];
        conv3x8(r_x1a, t0, w[2][0], w[2][1], w[2][2], w[2][3], xa); conv3x8(r_va, t0, w[4][0], w[4][1], w[4][2], w[4][3], va);
        conv3x8(r_x1b, t0, w[3][0], w[3][1], w[3][2], w[3][3], xb); conv3x8(r_vb, t0, w[5][0], w[5][1], w[5][2], w[5][3], vb);
        conv3x8(r_x0a, t0, w[0][0], w[0][1], w[0][2], w[0][3], ga); conv3x8(r_x0b, t0, w[1][0], w[1][1], w[1][2], w[1][3], gb);
        float oa[8], ob[8];
#pragma unroll
        for (int e = 0; e < 8; ++e) { const cf2 y = buf[SW(t0 + e)]; oa[e] = ga[e] * (y.x + ska * xa[e] * va[e]); ob[e] = gb[e] * (y.y + skb * xb[e] * vb[e]); }
        *(u32x4*)(yht + (size_t)c1 * T + t0) = (u32x4){pk_bf16(oa[0], oa[1]), pk_bf16(oa[2], oa[3]), pk_bf16(oa[4], oa[5]), pk_bf16(oa[6], oa[7])};
        *(u32x4*)(yht + (size_t)(c1 + 1) * T + t0) = (u32x4){pk_bf16(ob[0], ob[1]), pk_bf16(ob[2], ob[3]), pk_bf16(ob[4], ob[5]), pk_bf16(ob[6], ob[7])}; }
    __syncthreads();
}
DI void yh_transpose_item(const Params& p, int item, LAS unsigned char* lds, int tid) {
    __syncthreads();
    const int c0 = (item & 15) * 64, t0 = (item >> 4) * 64;
    LAS bf16_t* tile = (LAS bf16_t*)lds;
    { const int c = tid >> 3, seg = tid & 7;
      *(LAS u32x4*)(tile + c * 72 + 8 * seg) = *(const u32x4*)((const bf16_t*)(p.ws + O_KT) + (size_t)(c0 + c) * T + t0 + 8 * seg); }
    __syncthreads();
    { const int t = tid >> 3, seg = tid & 7; unsigned w[4];
#pragma unroll
      for (int j = 0; j < 4; ++j) w[j] = (unsigned)tile[(8 * seg + 2 * j) * 72 + t] | ((unsigned)tile[(8 * seg + 2 * j + 1) * 72 + t] << 16);
      *(u32x4*)((bf16_t*)(p.ws + O_YH) + (size_t)(t0 + t) * 1024 + c0 + 8 * seg) = (u32x4){w[0], w[1], w[2], w[3]}; }
}

constexpr int MC_KS = 528, MC_VS = 272, MC_PS = 272;
DI float mlstm_gates(const Params& p, int l, int dir, int head, int t_base, LAS float* li, LAS float* bb, int lane) {
    const float* MG = (const float*)(p.ws + O_MG); const float* bias = p.in[I_MGB] + l * 16;
    float lfv[2], liv[2];
#pragma unroll
    for (int u = 0; u < 2; ++u) { const int r = 2 * lane + u, rho = dir ? 127 - r : r, t = t_base + rho;
        const float gi = MG[t * 16 + dir * 8 + head] + bias[dir * 8 + head], gf = MG[t * 16 + dir * 8 + 4 + head] + bias[dir * 8 + 4 + head];
        liv[u] = gi; lfv[u] = fminf(gf, 0.f) - log1pf(expf(-fabsf(gf))); }
    const float s1 = lfv[0] + lfv[1];
    const float inc = wave_scan_add(s1, lane), exc = inc - s1;
    bb[2 * lane] = exc + lfv[0]; bb[2 * lane + 1] = inc; li[2 * lane] = liv[0]; li[2 * lane + 1] = liv[1];
    return inc;
}
DI u32x4 tr_read2(unsigned a0, unsigned a1) { u32x2 lo, hi;
    asm volatile("ds_read_b64_tr_b16 %0, %2\n\tds_read_b64_tr_b16 %1, %3\n\ts_waitcnt lgkmcnt(0)" : "=&v"(lo), "=&v"(hi) : "v"(a0), "v"(a1) : "memory");
    return (u32x4){lo[0], lo[1], hi[0], hi[1]}; }
DI void mlstm_passA(const Params& p, int l, int item, LAS unsigned char* lds, int tid) {
    __syncthreads();
    const int dir = item >> 8, head = (item >> 6) & 3, cv = item & 63, cact = dir ? 63 - cv : cv, t_base = cact * 128;
    const int wid = __builtin_amdgcn_readfirstlane(tid >> 6), lane = tid & 63;
    LAS unsigned char* Kl = lds;
    LAS float* li = (LAS float*)(lds + 128 * MC_KS); LAS float* bb = li + 128; LAS float* wact = bb + 128;
    if (wid == 0) {
        const float inc = mlstm_gates(p, l, dir, head, t_base, li, bb, lane);
        const float blast = __shfl(inc, 63);
        const float lw0 = blast - bb[2 * lane] + li[2 * lane], lw1 = blast - bb[2 * lane + 1] + li[2 * lane + 1];
        const float ml = wave_max(fmaxf(lw0, lw1));
        const int r0 = 2 * lane, r1 = 2 * lane + 1;
        wact[dir ? 127 - r0 : r0] = expf(lw0 - ml); wact[dir ? 127 - r1 : r1] = expf(lw1 - ml);
        if (lane == 0) { ((float*)(p.ws + O_MLOC))[item] = ml; ((float*)(p.ws + O_BLAST))[item] = blast; }
    }
    { const bf16_t* Kg = (const bf16_t*)(p.ws + O_K) + (size_t)t_base * 1024 + head * 256;
#pragma unroll
      for (int i = 0; i < 8; ++i) { const int idx = tid + 512 * i, rho = idx >> 5, c16 = idx & 31;
          *(LAS u32x4*)(Kl + rho * MC_KS + c16 * 16) = *(const u32x4*)(Kg + (size_t)rho * 1024 + c16 * 8); } }
    __syncthreads();
    const bf16_t* VT = (const bf16_t*)(p.ws + O_VT) + (size_t)head * 256 * T + t_base;
    const int wr = wid >> 1, wc = wid & 1, rl = lane & 15, g = lane >> 4;
    const unsigned kbase = (unsigned)(size_t)Kl + (unsigned)((8 * g + (rl >> 2)) * MC_KS + (128 * wc + 4 * (rl & 3)) * 2);
    f32x4 acc[4][8];
#pragma unroll
    for (int a = 0; a < 4; ++a)
#pragma unroll
        for (int b = 0; b < 8; ++b) acc[a][b] = (f32x4){0.f, 0.f, 0.f, 0.f};
#pragma unroll 1
    for (int ks = 0; ks < 4; ++ks) {
        const int rho0 = 32 * ks + 8 * g;
        float wv[8];
#pragma unroll
        for (int j = 0; j < 8; ++j) wv[j] = wact[rho0 + j];
        bf16x8 af[4];
#pragma unroll
        for (int mt = 0; mt < 4; ++mt) af[mt] = *(const bf16x8*)(VT + (size_t)(64 * wr + 16 * mt + rl) * T + rho0);
#pragma unroll
        for (int nt = 0; nt < 8; ++nt) {
            const unsigned a0 = kbase + (unsigned)(32 * ks * MC_KS + 32 * nt);
            const u32x4 kw = tr_read2(a0, a0 + 4 * MC_KS);
            u32x4 sw;
#pragma unroll
            for (int q = 0; q < 4; ++q) sw[q] = pk_bf16(bf_lo(kw[q]) * wv[2 * q], bf_hi(kw[q]) * wv[2 * q + 1]);
            const bf16x8 bfr = __builtin_bit_cast(bf16x8, sw);
#pragma unroll
            for (int mt = 0; mt < 4; ++mt) acc[mt][nt] = __builtin_amdgcn_mfma_f32_16x16x32_bf16(bfr, af[mt], acc[mt][nt], 0, 0, 0);
        }
    }
    bf16_t* KVu = (bf16_t*)(p.ws + O_KV) + (size_t)item * 65536 + (64 * wr) * 256 + 128 * wc;
    const int loff = rl * 256 + 4 * g;
#pragma unroll
    for (int mt = 0; mt < 4; ++mt) { bf16_t* rowp = KVu + (16 * mt) * 256;
#pragma unroll
        for (int nt = 0; nt < 8; ++nt) *(u32x2*)(rowp + loff + 16 * nt) = (u32x2){pk_bf16(acc[mt][nt][0], acc[mt][nt][1]), pk_bf16(acc[mt][nt][2], acc[mt][nt][3])}; }
    if (tid < 256) { float s = 0.f;
#pragma unroll 8
        for (int rho = 0; rho < 128; ++rho) s += wact[rho] * __uint_as_float(((unsigned)*(const LAS bf16_t*)(Kl + rho * MC_KS + 2 * tid)) << 16);
        ((float*)(p.ws + O_NLOC))[(size_t)item * 256 + tid] = s; }
    __syncthreads();
}
DI void mlstm_passB(const Params& p, int gtid, int gthreads, int bid, int tid) {
    const float* MLOC = (const float*)(p.ws + O_MLOC); const float* BLAST = (const float*)(p.ws + O_BLAST);
    if (tid >= 64 && tid < 66 && bid * 2 + (tid - 64) < 512) {
        const int v = bid * 2 + (tid - 64), dh = v >> 6, off = (v & 63) * 4;
        const float* NL_ = (const float*)(p.ws + O_NLOC) + (size_t)dh * 64 * 256 + off;
        float* NST = (float*)(p.ws + O_NST) + (size_t)dh * 64 * 256 + off;
        f32x4 n = (f32x4){0.f, 0.f, 0.f, 0.f}; float m = 0.f;
#pragma unroll 1
        for (int c0 = 0; c0 < 64; c0 += 16) {
            f32x4 nl[16]; float bl[16], ml[16];
#pragma unroll
            for (int k = 0; k < 16; ++k) { nl[k] = *(const f32x4*)(NL_ + (size_t)(c0 + k) * 256); bl[k] = BLAST[dh * 64 + c0 + k]; ml[k] = MLOC[dh * 64 + c0 + k]; }
#pragma unroll
            for (int k = 0; k < 16; ++k) { const int c = c0 + k;
                *(f32x4*)(NST + (size_t)c * 256) = n;
                if (off == 0) ((float*)(p.ws + O_MST))[dh * 64 + c] = m;
                const float mn = fmaxf(bl[k] + m, ml[k]);
                n = expf(bl[k] + m - mn) * n + expf(ml[k] - mn) * nl[k]; m = mn; }
        }
    }
    for (int w = gtid; w < 8 * 16384; w += gthreads) {
        const int dh = w >> 14, off = (w & 16383) * 4;
        const bf16_t* KV = (const bf16_t*)(p.ws + O_KV) + (size_t)dh * 64 * 65536 + off;
        bf16_t* CST = (bf16_t*)(p.ws + O_CST) + (size_t)dh * 64 * 65536 + off;
        f32x4 C = (f32x4){0.f, 0.f, 0.f, 0.f}; float m = 0.f;
#pragma unroll 1
        for (int c0 = 0; c0 < 64; c0 += 16) {
            u32x2 kw[16];
#pragma unroll
            for (int k = 0; k < 16; ++k) kw[k] = *(const u32x2*)(KV + (size_t)(c0 + k) * 65536);
#pragma unroll
            for (int k = 0; k < 16; ++k) { const int c = c0 + k; const f32x4 kv = (f32x4){bf_lo(kw[k][0]), bf_hi(kw[k][0]), bf_lo(kw[k][1]), bf_hi(kw[k][1])};
                *(u32x2*)(CST + (size_t)c * 65536) = (u32x2){pk_bf16(C[0], C[1]), pk_bf16(C[2], C[3])};
                const float bl = BLAST[dh * 64 + c], ml = MLOC[dh * 64 + c], mn = fmaxf(bl + m, ml);
                const float dk = expf(bl + m - mn), sk = expf(ml - mn);
                C = dk * C + sk * kv; m = mn; }
        }
    }
}
DI void mlstm_passC(const Params& p, int l, int item, LAS unsigned char* lds, int tid) {
    __syncthreads();
    const int dir = item >> 8, head = (item >> 6) & 3, cv = item & 63, cact = dir ? 63 - cv : cv, t_base = cact * 128;
    const int wid = __builtin_amdgcn_readfirstlane(tid >> 6), lane = tid & 63, rl = lane & 15, g = lane >> 4;
    constexpr int RA = 256 * MC_VS;
    LAS unsigned char* Kl = lds;
    LAS unsigned char* Vl = lds;
    LAS unsigned char* Pw = lds + RA + wid * 16 * MC_PS;
    LAS float* sc = (LAS float*)(lds + 2 * RA);
    LAS float* li = sc; LAS float* bb = sc + 128; LAS float* av = sc + 256; LAS float* Mx = sc + 384; LAS float* inter = sc + 512; LAS float* en = sc + 640;
    LAS float* nst = sc + 768; LAS float* qn = sc + 1024;
    const float mstate = ((const float*)(p.ws + O_MST))[item];
    if (wid == 0) {
        mlstm_gates(p, l, dir, head, t_base, li, bb, lane);
        const float a0 = li[2 * lane] - bb[2 * lane], a1 = li[2 * lane + 1] - bb[2 * lane + 1];
        const float pm = fmaxf(a0, a1), inc = wave_scan_max(pm, lane);
        float exc = __shfl_up(inc, 1); if (lane == 0) exc = -3.0e38f;
        const float M0 = fmaxf(mstate, fmaxf(exc, a0)), M1 = fmaxf(mstate, inc);
        av[2 * lane] = a0; av[2 * lane + 1] = a1; Mx[2 * lane] = M0; Mx[2 * lane + 1] = M1;
        inter[2 * lane] = expf(mstate - M0); inter[2 * lane + 1] = expf(mstate - M1);
        en[2 * lane] = expf(-(bb[2 * lane] + M0)); en[2 * lane + 1] = expf(-(bb[2 * lane + 1] + M1));
    }
    {
        const bf16_t* Kg = (const bf16_t*)(p.ws + O_K) + head * 256;
#pragma unroll
        for (int i = 0; i < 8; ++i) { const int idx = tid + 512 * i, s = idx >> 5, c16 = idx & 31; const int t = t_base + (dir ? 127 - s : s);
            *(LAS u32x4*)(Kl + s * MC_KS + c16 * 16) = *(const u32x4*)(Kg + (size_t)t * 1024 + c16 * 8); }
        if (tid < 256) nst[tid] = ((const float*)(p.ws + O_NST))[(size_t)item * 256 + tid];
    }
    __syncthreads();
    bf16x8 qa[8];
    { const int r = 16 * wid + rl, t = t_base + (dir ? 127 - r : r); const bf16_t* qr = (const bf16_t*)(p.ws + O_Q) + (size_t)t * 1024 + head * 256 + 8 * g;
#pragma unroll
      for (int kk = 0; kk < 8; ++kk) qa[kk] = *(const bf16x8*)(qr + 32 * kk); }
    { float s = 0.f;
#pragma unroll
      for (int kk = 0; kk < 8; ++kk) { const u32x4 w = __builtin_bit_cast(u32x4, qa[kk]);
#pragma unroll
          for (int e = 0; e < 4; ++e) s += bf_lo(w[e]) * nst[32 * kk + 8 * g + 2 * e] + bf_hi(w[e]) * nst[32 * kk + 8 * g + 2 * e + 1]; }
      s += __shfl_xor(s, 16); s += __shfl_xor(s, 32);
      if (g == 0) qn[wid * 16 + rl] = s; }
    float rs[4] = {0.f, 0.f, 0.f, 0.f};
    float Mr[4], ir[4];
#pragma unroll
    for (int j = 0; j < 4; ++j) { Mr[j] = Mx[16 * wid + 4 * g + j]; ir[j] = inter[16 * wid + 4 * g + j]; }
#pragma unroll
    for (int nt = 0; nt < 8; ++nt) if (nt <= wid + 1) {
        f32x4 st = (f32x4){0.f, 0.f, 0.f, 0.f};
        if (nt <= wid) {
#pragma unroll
            for (int kk = 0; kk < 8; ++kk) st = __builtin_amdgcn_mfma_f32_16x16x32_bf16(qa[kk], *(const LAS bf16x8*)(Kl + (16 * nt + rl) * MC_KS + kk * 64 + g * 16), st, 0, 0, 0);
            const int s = 16 * nt + rl; const float as = av[s];
#pragma unroll
            for (int j = 0; j < 4; ++j) { const int r = 16 * wid + 4 * g + j; const float v = (s <= r) ? st[j] * expf(as - Mr[j]) : 0.f; st[j] = v; rs[j] += v; }
        }
#pragma unroll
        for (int j = 0; j < 4; ++j) *(LAS bf16_t*)(Pw + (4 * g + j) * MC_PS + (16 * nt + rl) * 2) = (bf16_t)(pk_bf16(st[j], 0.f) & 0xffffu);
    }
#pragma unroll
    for (int j = 0; j < 4; ++j) { float v = rs[j]; v += __shfl_xor(v, 1); v += __shfl_xor(v, 2); v += __shfl_xor(v, 4); v += __shfl_xor(v, 8); rs[j] = v; }
    f32x4 acc[16];
    const bf16_t* CST = (const bf16_t*)(p.ws + O_CST) + (size_t)item * 65536;
#pragma unroll
    for (int hf = 0; hf < 2; ++hf) {
        __syncthreads();
#pragma unroll
        for (int i = 0; i < 8; ++i) { const int idx = tid + 512 * i, e = idx >> 5, c16 = idx & 31;
            *(LAS u32x4*)(Kl + e * MC_KS + c16 * 16) = *(const u32x4*)(CST + (size_t)(128 * hf + e) * 256 + c16 * 8); }
        __syncthreads();
#pragma unroll
        for (int n8 = 0; n8 < 8; ++n8) { const int n2 = 8 * hf + n8;
            acc[n2] = (f32x4){0.f, 0.f, 0.f, 0.f};
#pragma unroll
            for (int kk = 0; kk < 8; ++kk) acc[n2] = __builtin_amdgcn_mfma_f32_16x16x32_bf16(qa[kk], *(const LAS bf16x8*)(Kl + (16 * n8 + rl) * MC_KS + kk * 64 + g * 16), acc[n2], 0, 0, 0);
#pragma unroll
            for (int j = 0; j < 4; ++j) acc[n2][j] *= ir[j];
        }
    }
    __syncthreads();
    {
        const bf16_t* VT = (const bf16_t*)(p.ws + O_VT) + (size_t)head * 256 * T + t_base;
#pragma unroll
        for (int i = 0; i < 8; ++i) { const int idx = tid + 512 * i, e = idx >> 4, seg = idx & 15;
            u32x4 v = *(const u32x4*)(VT + (size_t)e * T + 8 * seg); int s0 = 8 * seg;
            if (dir) { v = (u32x4){__builtin_rotateleft32(v[3], 16), __builtin_rotateleft32(v[2], 16), __builtin_rotateleft32(v[1], 16), __builtin_rotateleft32(v[0], 16)}; s0 = 120 - 8 * seg; }
            *(LAS u32x4*)(Vl + e * MC_VS + s0 * 2) = v; }
    }
    __syncthreads();
    const int nks = (wid >> 1) + 1;
#pragma unroll
    for (int ks = 0; ks < 4; ++ks) if (ks < nks) {
        const bf16x8 pa = *(const LAS bf16x8*)(Pw + rl * MC_PS + ks * 64 + g * 16);
#pragma unroll
        for (int n2 = 0; n2 < 16; ++n2) acc[n2] = __builtin_amdgcn_mfma_f32_16x16x32_bf16(pa, *(const LAS bf16x8*)(Vl + (16 * n2 + rl) * MC_VS + ks * 64 + g * 16), acc[n2], 0, 0, 0);
    }
    float* HD = (float*)(p.ws + O_HDIR) + (size_t)dir * T * 1024 + head * 256;
#pragma unroll
    for (int j = 0; j < 4; ++j) { const int r = 16 * wid + 4 * g + j, t = t_base + (dir ? 127 - r : r);
        const float den = rs[j] + ir[j] * qn[wid * 16 + 4 * g + j]; const float dd = 1.0f / fmaxf(fabsf(den), en[r]);
#pragma unroll
        for (int n2 = 0; n2 < 16; ++n2) HD[(size_t)t * 1024 + 16 * n2 + rl] = acc[n2][j] * dd; }
    __syncthreads();
}
DI void mlstm_final(const Params& p, int l, int t, int lane) {
    const float* h0 = (const float*)(p.ws + O_HDIR) + (size_t)t * 1024 + 16 * lane; const float* h1 = h0 + (size_t)T * 1024;
    const bf16_t* o = (const bf16_t*)(p.ws + O_O) + (size_t)t * 1024 + 16 * lane; const float* gain = p.in[I_MNG] + l * 1024 + 16 * lane;
    float v[16];
    const u32x4 o0 = *(const u32x4*)o, o1 = *(const u32x4*)(o + 8);
#pragma unroll
    for (int q = 0; q < 4; ++q) { const f32x4 a = *(const f32x4*)(h0 + 4 * q), b = *(const f32x4*)(h1 + 4 * q);
#pragma unroll
        for (int e = 0; e < 4; ++e) v[4 * q + e] = a[e] + b[e]; }
#pragma unroll
    for (int q = 0; q < 4; ++q) { v[2 * q] *= sigmoidf_(bf_lo(o0[q])); v[2 * q + 1] *= sigmoidf_(bf_hi(o0[q])); v[8 + 2 * q] *= sigmoidf_(bf_lo(o1[q])); v[8 + 2 * q + 1] *= sigmoidf_(bf_hi(o1[q])); }
    float s = 0.f;
#pragma unroll
    for (int e = 0; e < 16; ++e) s += v[e];
    s += __shfl_xor(s, 1); s += __shfl_xor(s, 2); s += __shfl_xor(s, 4); s += __shfl_xor(s, 8);
    const float mu = s * (1.0f / 256.0f);
    float q2 = 0.f;
#pragma unroll
    for (int e = 0; e < 16; ++e) { v[e] -= mu; q2 += v[e] * v[e]; }
    q2 += __shfl_xor(q2, 1); q2 += __shfl_xor(q2, 2); q2 += __shfl_xor(q2, 4); q2 += __shfl_xor(q2, 8);
    const float rstd = rsqrtf(q2 * (1.0f / 256.0f) + LN_EPS);
    u32x4 w0, w1;
#pragma unroll
    for (int q = 0; q < 4; ++q) { w0[q] = pk_bf16(v[2 * q] * rstd * gain[2 * q], v[2 * q + 1] * rstd * gain[2 * q + 1]); w1[q] = pk_bf16(v[8 + 2 * q] * rstd * gain[8 + 2 * q], v[9 + 2 * q] * rstd * gain[9 + 2 * q]); }
    bf16_t* hn = (bf16_t*)(p.ws + O_HN) + (size_t)t * 1024 + 16 * lane;
    *(u32x4*)hn = w0; *(u32x4*)(hn + 8) = w1;
}

struct S5Coef { cf2 a; cf2 bbar[16]; };
DI void s5_coefs(const Params& p, int l, int dir, int g, int lane, S5Coef& c) {
    const size_t gi = ((size_t)l * 2 + dir) * 64 + g;
    const float step = expf(p.in[I_SLS][gi]);
    const float lr = p.in[I_SLR][gi * 64 + lane], lim = p.in[I_SLI][gi * 64 + lane];
    const float ar = lr * step, ai = lim * step;
    float sn, cs; sincosf(ai, &sn, &cs);
    const float ea = expf(ar);
    c.a = mk2(ea * cs, ea * sn);
    const float sh = sinf(0.5f * ai);
    const float nr = expm1f(ar) * cs - 2.0f * sh * sh, ni = ea * sn;
    const float inv = 1.0f / (lr * lr + lim * lim);
    const cf2 coef = mk2((nr * lr + ni * lim) * inv, (ni * lr - nr * lim) * inv);
    const float* br = p.in[I_SBR] + (gi * 64 + lane) * 16; const float* bi = p.in[I_SBI] + (gi * 64 + lane) * 16;
#pragma unroll
    for (int q = 0; q < 4; ++q) { const f32x4 r4 = *(const f32x4*)(br + 4 * q), i4 = *(const f32x4*)(bi + 4 * q);
#pragma unroll
        for (int e = 0; e < 4; ++e) c.bbar[4 * q + e] = cmul(coef, mk2(r4[e], i4[e])); }
}
DI void s5_prep_item(const Params& p, int item, LAS unsigned char* lds, int tid) {
    __syncthreads();
    const int l = item >> 6, g = item & 63;
    LAS cf2* Bb = (LAS cf2*)lds;
    LAS cf2* Cc = Bb + 2048;
    LAS cf2* Aa = Cc + 2048;
    LAS float* Kl = (LAS float*)(Aa + 128);
    if (tid < 128) { const int d = tid >> 6, pp = tid & 63; S5Coef cf; s5_coefs(p, l, d, g, pp, cf); Aa[tid] = cf.a;
#pragma unroll
        for (int m = 0; m < 16; ++m) Bb[tid * 16 + m] = cf.bbar[m]; }
#pragma unroll
    for (int i = 0; i < 4; ++i) { const int idx = tid + 512 * i, d = idx >> 10; const size_t gi = ((size_t)l * 2 + d) * 64 + g;
        Cc[idx] = mk2(p.in[I_SCR][gi * 1024 + (idx & 1023)], p.in[I_SCI][gi * 1024 + (idx & 1023)]); }
    __syncthreads();
    {
        const int d = tid >> 8, n = (tid >> 4) & 15, m = tid & 15;
        float Ka[16];
#pragma unroll
        for (int j = 0; j < 16; ++j) Ka[j] = 0.f;
        for (int pp = 0; pp < 64; ++pp) { cf2 z = cmul(Cc[(d * 16 + n) * 64 + pp], Bb[(d * 64 + pp) * 16 + m]); const cf2 a = Aa[d * 64 + pp];
#pragma unroll
            for (int j = 0; j < 16; ++j) { Ka[j] += z.x; z = cmul(z, a); } }
#pragma unroll
        for (int j = 0; j < 16; ++j) Kl[((d * 16 + j) * 16 + n) * 16 + m] = Ka[j];
    }
    __syncthreads();
    bf16_t* W = (bf16_t*)(p.ws + O_S5W) + ((size_t)l * 64 + g) * 256 * 512;
    bf16_t* E = (bf16_t*)(p.ws + O_S5E) + ((size_t)l * 64 + g) * 256 * 256;
    const float* skip = p.in[I_SSK] + l * 1024 + 16 * g;
#pragma unroll 1
    for (int i = 0; i < 64; ++i) { const int idx = tid + 512 * i, row = idx >> 7, k = (idx & 127) * 2, sr = row >> 4, n = row & 15, s2 = k >> 4, m = k & 15;
        float v0 = 0.f, v1 = 0.f;
        if (s2 <= sr) { v0 += Kl[((sr - s2) * 16 + n) * 16 + m]; v1 += Kl[((sr - s2) * 16 + n) * 16 + m + 1]; }
        if (s2 >= sr) { v0 += Kl[((16 + s2 - sr) * 16 + n) * 16 + m]; v1 += Kl[((16 + s2 - sr) * 16 + n) * 16 + m + 1]; }
        if (s2 == sr) { if (m == n) v0 += skip[n]; if (m + 1 == n) v1 += skip[n]; }
        *(unsigned*)(W + (size_t)row * 512 + k) = pk_bf16(v0, v1); }
#pragma unroll 1
    for (int i = 0; i < 4; ++i) { const int idx = tid + 512 * i, d = idx >> 10, n = (idx >> 6) & 15, pp = idx & 63;
        const cf2 a = Aa[d * 64 + pp]; cf2 z = cmul(Cc[(d * 16 + n) * 64 + pp], a);
#pragma unroll 1
        for (int e = 1; e <= 16; ++e) { const int sr = d == 0 ? e - 1 : 16 - e; bf16_t* w = W + (size_t)(sr * 16 + n) * 512 + 256 + d * 128 + pp;
            w[0] = (bf16_t)(pk_bf16(z.x, 0.f) & 0xffffu); w[64] = (bf16_t)(pk_bf16(-z.y, 0.f) & 0xffffu); z = cmul(z, a); } }
#pragma unroll 1
    for (int i = 0; i < 4; ++i) { const int idx = tid + 512 * i, d = idx >> 10, pp = (idx >> 4) & 63, m = idx & 15;
        const cf2 a = Aa[d * 64 + pp]; cf2 z = Bb[(d * 64 + pp) * 16 + m];
#pragma unroll 1
        for (int e = 0; e < 16; ++e) { const int s2 = d == 0 ? 15 - e : e; bf16_t* w = E + (size_t)(d * 128 + pp) * 256 + s2 * 16 + m;
            w[0] = (bf16_t)(pk_bf16(z.x, 0.f) & 0xffffu); w[(size_t)64 * 256] = (bf16_t)(pk_bf16(z.y, 0.f) & 0xffffu); z = cmul(z, a); } }
    __syncthreads();
}
template <int MODE>
DI void s5_mm(const Params& p, int l, int item, int tid) {
    constexpr int K = MODE ? 512 : 256;
    const int g = item >> 3, bt = item & 7, wid = __builtin_amdgcn_readfirstlane(tid >> 6), lane = tid & 63, fr = lane & 15, fq = lane >> 4;
    const int b0 = 64 * bt;
    const bf16_t* Ua = (const bf16_t*)(p.ws + O_SU) + ((size_t)g * 512 + b0 + fr) * 256 + 8 * fq;
    const bf16_t* Xa = (const bf16_t*)(p.ws + O_XIN) + ((size_t)g * 512 + b0 + fr) * 256 + 8 * fq;
    const bf16_t* Bw = (MODE ? (const bf16_t*)(p.ws + O_S5W) + ((size_t)l * 64 + g) * 256 * 512 : (const bf16_t*)(p.ws + O_S5E) + ((size_t)l * 64 + g) * 256 * 256) + (size_t)(32 * wid + fr) * K + 8 * fq;
    f32x4 acc[4][2];
#pragma unroll
    for (int r = 0; r < 4; ++r) { acc[r][0] = (f32x4){0.f, 0.f, 0.f, 0.f}; acc[r][1] = (f32x4){0.f, 0.f, 0.f, 0.f}; }
#pragma unroll 4
    for (int ks = 0; ks < K / 32; ++ks) {
        const bf16_t* ap = (ks < 8) ? Ua + 32 * ks : Xa + 32 * (ks - 8);
        const bf16x8 w0 = *(const bf16x8*)(Bw + 32 * ks), w1 = *(const bf16x8*)(Bw + (size_t)16 * K + 32 * ks);
#pragma unroll
        for (int r = 0; r < 4; ++r) { const bf16x8 af = *(const bf16x8*)(ap + (size_t)(16 * r) * 256);
            acc[r][0] = __builtin_amdgcn_mfma_f32_16x16x32_bf16(w0, af, acc[r][0], 0, 0, 0);
            acc[r][1] = __builtin_amdgcn_mfma_f32_16x16x32_bf16(w1, af, acc[r][1], 0, 0, 0); }
    }
    if (MODE == 0) {
#pragma unroll
        for (int r = 0; r < 4; ++r) { float* xe = (float*)(p.ws + O_XE) + ((size_t)g * 512 + b0 + 16 * r + fr) * 256 + 32 * wid + 4 * fq;
            *(f32x4*)xe = acc[r][0]; *(f32x4*)(xe + 16) = acc[r][1]; }
    } else {
#pragma unroll
        for (int r = 0; r < 4; ++r) { bf16_t* ys = (bf16_t*)(p.ws + O_YS) + (size_t)(16 * (b0 + 16 * r + fr) + 2 * wid) * 1024 + 16 * g + 4 * fq;
            *(u32x2*)ys = (u32x2){pk_bf16(acc[r][0][0], acc[r][0][1]), pk_bf16(acc[r][0][2], acc[r][0][3])};
            *(u32x2*)(ys + 1024) = (u32x2){pk_bf16(acc[r][1][0], acc[r][1][1]), pk_bf16(acc[r][1][2], acc[r][1][3])}; }
    }
}
DI void s5_scan(const Params& p, int l, int idx) {
    const int g = idx >> 7, d = (idx >> 6) & 1, pp = idx & 63;
    const size_t gi = ((size_t)l * 2 + d) * 64 + g;
    const float step = expf(p.in[I_SLS][gi]);
    const float ar = p.in[I_SLR][gi * 64 + pp] * step, ai = p.in[I_SLI][gi * 64 + pp] * step;
    float sn, cs; sincosf(ai, &sn, &cs); const float ea = expf(ar);
    cf2 a = mk2(ea * cs, ea * sn);
#pragma unroll
    for (int i = 0; i < 4; ++i) a = cmul(a, a);
    const float* __restrict__ xe = (const float*)(p.ws + O_XE) + (size_t)g * 512 * 256 + d * 128 + pp;
    bf16_t* __restrict__ xi = (bf16_t*)(p.ws + O_XIN) + (size_t)g * 512 * 256 + d * 128 + pp;
    cf2 X = mk2(0.f, 0.f);
#pragma unroll 1
    for (int i0 = 0; i0 < 512; i0 += 64) {
        float er[64], ei[64];
#pragma unroll
        for (int k = 0; k < 64; ++k) { const int b = d ? 511 - (i0 + k) : i0 + k; er[k] = xe[(size_t)b * 256]; ei[k] = xe[(size_t)b * 256 + 64]; }
#pragma unroll
        for (int k = 0; k < 64; ++k) { const int b = d ? 511 - (i0 + k) : i0 + k;
            xi[(size_t)b * 256] = (bf16_t)(pk_bf16(X.x, 0.f) & 0xffffu); xi[(size_t)b * 256 + 64] = (bf16_t)(pk_bf16(X.y, 0.f) & 0xffffu);
            X = cmul(a, X); X.x += er[k]; X.y += ei[k]; }
    }
}

template <int W>
DI void ln_store(float (&v)[32], const float* __restrict__ gam, const float* __restrict__ bet, float* dstf, bf16_t* dstb, int lane) {
    float s = 0.f;
#pragma unroll
    for (int i = 0; i < 32; ++i) s += v[i];
    const float mu = wave_sum(s) * (1.0f / 2048.0f);
    float q = 0.f;
#pragma unroll
    for (int i = 0; i < 32; ++i) { v[i] -= mu; q += v[i] * v[i]; }
    const float rstd = rsqrtf(wave_sum(q) * (1.0f / 2048.0f) + LN_EPS);
#pragma unroll
    for (int c = 0; c < 32 / W; ++c)
#pragma unroll
        for (int h = 0; h < W / 8; ++h) { const int o = 64 * W * c + W * lane + 8 * h, vi = W * c + 8 * h;
            const f32x4 g0 = *(const f32x4*)(gam + o), g1 = *(const f32x4*)(gam + o + 4), b0 = *(const f32x4*)(bet + o), b1 = *(const f32x4*)(bet + o + 4);
            f32x4 r0, r1;
#pragma unroll
            for (int e = 0; e < 4; ++e) { r0[e] = v[vi + e] * rstd * g0[e] + b0[e]; r1[e] = v[vi + 4 + e] * rstd * g1[e] + b1[e]; }
            *(f32x4*)(dstf + o) = r0; *(f32x4*)(dstf + o + 4) = r1;
            if (dstb) *(u32x4*)(dstb + o) = (u32x4){pk_bf16(r0[0], r0[1]), pk_bf16(r0[2], r0[3]), pk_bf16(r1[0], r1[1]), pk_bf16(r1[2], r1[3])}; }
}
template <int W>
DI void load_row32(const float* __restrict__ src, float (&v)[32], int lane) {
#pragma unroll
    for (int c = 0; c < 32 / W; ++c)
#pragma unroll
        for (int h = 0; h < W / 4; ++h) { const f32x4 a = *(const f32x4*)(src + 64 * W * c + W * lane + 4 * h);
#pragma unroll
            for (int e = 0; e < 4; ++e) v[W * c + 4 * h + e] = a[e]; }
}

constexpr int PB = 8;
DI void load_ln_row16(const float* __restrict__ src, const float* __restrict__ gam, const float* __restrict__ bet, float (&v)[32], int lane) {
    load_row32<16>(src, v, lane);
    float s = 0.f;
#pragma unroll
    for (int i = 0; i < 32; ++i) s += v[i];
    const float mu = wave_sum(s) * (1.0f / 2048.0f);
    float q = 0.f;
#pragma unroll
    for (int i = 0; i < 32; ++i) { v[i] -= mu; q += v[i] * v[i]; }
    const float rstd = rsqrtf(wave_sum(q) * (1.0f / 2048.0f) + LN_EPS);
#pragma unroll
    for (int c = 0; c < 2; ++c)
#pragma unroll
        for (int h = 0; h < 4; ++h) { const int o = 1024 * c + 16 * lane + 4 * h; const f32x4 g = *(const f32x4*)(gam + o), b = *(const f32x4*)(bet + o);
#pragma unroll
            for (int e = 0; e < 4; ++e) v[16 * c + 4 * h + e] = v[16 * c + 4 * h + e] * rstd * g[e] + b[e]; }
}
DI unsigned f2ord(float f) { const unsigned u = __float_as_uint(f); return (u & 0x80000000u) ? ~u : (u | 0x80000000u); }
DI float ord2f(unsigned k) { const unsigned u = (k & 0x80000000u) ? (k & 0x7fffffffu) : ~k; return __uint_as_float(u); }
#define INS16(L, key) do { unsigned k_ = (key); _Pragma("unroll") for (int q_ = 0; q_ < 16; ++q_) { const unsigned mx_ = max(L[q_], k_); k_ = min(L[q_], k_); L[q_] = mx_; } } while (0)
#define CE16(A, a, b) do { const unsigned hi_ = max(A[a], A[b]), lo_ = min(A[a], A[b]); A[a] = hi_; A[b] = lo_; } while (0);
#define SORT16_DESC(N) do { CE16(N,0,1) CE16(N,2,3) CE16(N,4,5) CE16(N,6,7) CE16(N,8,9) CE16(N,10,11) CE16(N,12,13) CE16(N,14,15) CE16(N,0,2) CE16(N,1,3) CE16(N,4,6) CE16(N,5,7) CE16(N,8,10) CE16(N,9,11) CE16(N,12,14) CE16(N,13,15) CE16(N,1,2) CE16(N,5,6) CE16(N,9,10) CE16(N,13,14) CE16(N,0,4) CE16(N,1,5) CE16(N,2,6) CE16(N,3,7) CE16(N,8,12) CE16(N,9,13) CE16(N,10,14) CE16(N,11,15) CE16(N,2,4) CE16(N,3,5) CE16(N,10,12) CE16(N,11,13) CE16(N,1,2) CE16(N,3,4) CE16(N,5,6) CE16(N,9,10) CE16(N,11,12) CE16(N,13,14) CE16(N,0,8) CE16(N,1,9) CE16(N,2,10) CE16(N,3,11) CE16(N,4,12) CE16(N,5,13) CE16(N,6,14) CE16(N,7,15) CE16(N,4,8) CE16(N,5,9) CE16(N,6,10) CE16(N,7,11) CE16(N,2,4) CE16(N,3,5) CE16(N,6,8) CE16(N,7,9) CE16(N,10,12) CE16(N,11,13) CE16(N,1,2) CE16(N,3,4) CE16(N,5,6) CE16(N,7,8) CE16(N,9,10) CE16(N,11,12) CE16(N,13,14) } while (0)
DI float gelu_tanh(float x) { const float z = 0.7978845608028654f * (x + 0.044715f * x * x * x); const float th = 1.0f - 2.0f / (__expf(2.0f * z) + 1.0f); return 0.5f * x * (1.0f + th); }
DI void peer_item(const Params& p, int l, int item, const float* __restrict__ gam, const float* __restrict__ bet, float* outf, bf16_t* outb, LAS unsigned char* lds, int tid_in) {
    __syncthreads();
    int tid = tid_in; asm volatile("" : "+v"(tid));
    const int t0 = item * 32, wid = __builtin_amdgcn_readfirstlane(tid >> 6), lane = tid & 63;
    LAS unsigned* TK = (LAS unsigned*)lds;
    LAS unsigned* EXI = TK + 32 * 16 * 16;
    LAS float* EXG = (LAS float*)(EXI + 32 * 128);
    LAS float* CO = EXG + 32 * 128 + wid * 128;
    {
        const int tl = tid & 31, hc = tid >> 5;
        const bf16_t* sc = (const bf16_t*)(p.ws + O_SCT) + (size_t)(hc * 128) * SCT_LD + t0 + tl;
        unsigned L[16];
#pragma unroll
        for (int q = 0; q < 16; ++q) L[q] = 0u;
        unsigned R[16];
#pragma unroll
        for (int q = 0; q < 16; ++q) R[q] = (unsigned)sc[(size_t)q * SCT_LD];
#pragma unroll 1
        for (int kb = 0; kb < 128; kb += 16) {
            unsigned N[16];
#pragma unroll
            for (int q = 0; q < 16; ++q) { const float v = __uint_as_float(R[q] << 16); N[q] = (f2ord(v) & ~127u) | (unsigned)(127 - kb - q); }
            if (kb < 112) {
#pragma unroll
                for (int q = 0; q < 16; ++q) R[q] = (unsigned)sc[(size_t)(kb + 16 + q) * SCT_LD];
            }
            SORT16_DESC(N);
#pragma unroll
            for (int q = 0; q < 16; ++q) L[q] = max(L[q], N[15 - q]);
#pragma unroll
            for (int k = 8; k >= 1; k >>= 1)
#pragma unroll
                for (int q = 0; q < 16; ++q) if ((q & k) == 0) CE16(L, q, q + k);
        }
#pragma unroll
        for (int q = 0; q < 16; ++q) TK[(tl * 16 + hc) * 16 + q] = L[q];
    }
    __syncthreads();
    if (tid < 256) {
        const int tl = tid & 31, h = tid >> 5;
        LAS unsigned* A = TK + (tl * 16 + 2 * h) * 16; LAS unsigned* B = A + 16;
        float fa[16], fb[16];
#pragma unroll
        for (int i = 0; i < 16; ++i) { fa[i] = ord2f(A[i] & ~127u); fb[i] = ord2f(B[i] & ~127u); }
        unsigned W[16];
#pragma unroll
        for (int q = 0; q < 16; ++q) W[q] = 0u;
#pragma unroll
        for (int i = 0; i < 16; ++i)
#pragma unroll
            for (int j = 0; j < 16; ++j) if ((i + 1) * (j + 1) <= 16) INS16(W, (f2ord(fa[i] + fb[j]) & ~255u) | (unsigned)(255 - (i * 16 + j)));
        const float vmax = ord2f(W[0] & ~255u);
        float ex[16], sum = 0.f;
#pragma unroll
        for (int r = 0; r < 16; ++r) { ex[r] = __expf(ord2f(W[r] & ~255u) - vmax); sum += ex[r]; }
        const float rs = 1.0f / sum;
#pragma unroll
        for (int r = 0; r < 16; ++r) { const unsigned c = 255u - (W[r] & 255u); const unsigned i1 = 127u - (A[c >> 4] & 127u), i2 = 127u - (B[c & 15u] & 127u);
            EXI[tl * 128 + h * 16 + r] = i1 * 128u + i2; EXG[tl * 128 + h * 16 + r] = ex[r] * rs; }
    }
    __syncthreads();
    const unsigned char* U8 = p.ws + O_U16; const unsigned char* V8 = p.ws + O_V16;
    const float* US = (const float*)(p.ws + O_U16 + (size_t)16384 * 2048); const float* VS = (const float*)(p.ws + O_V16 + (size_t)16384 * 2048);
#pragma unroll 1
    for (int ti = 0; ti < 4; ++ti) {
        const int tl = 4 * wid + ti, t = t0 + tl;
        if (ti) __syncthreads();
        int ln = lane; asm volatile("" : "+v"(ln));
        {
            const unsigned id0 = EXI[tl * 128 + ln], id1 = EXI[tl * 128 + 64 + ln]; const float g0 = EXG[tl * 128 + ln], g1 = EXG[tl * 128 + 64 + ln];
            int r0 = 0, r1 = 0;
#pragma unroll 8
            for (int j = 0; j < 128; ++j) { const unsigned o = EXI[tl * 128 + j];
                r0 += (o < id0 || (o == id0 && j < ln)) ? 1 : 0; r1 += (o < id1 || (o == id1 && j < ln + 64)) ? 1 : 0; }
            __builtin_amdgcn_wave_barrier();
            EXI[tl * 128 + r0] = id0; EXG[tl * 128 + r0] = g0; EXI[tl * 128 + r1] = id1; EXG[tl * 128 + r1] = g1;
            __builtin_amdgcn_wave_barrier();
        }
        f32x2 xp[16];
        {
            float xf[32]; load_ln_row16((const float*)(p.ws + O_Y1) + (size_t)t * DM, p.in[I_L1G] + l * DM, p.in[I_L1B] + l * DM, xf, ln);
#pragma unroll
            for (int i = 0; i < 16; ++i) { xp[i].x = xf[2 * i]; xp[i].y = xf[2 * i + 1]; }
            const int eo = ((ln >> 5) & 1) * 4 + ((ln >> 4) & 1) * 2 + ((ln >> 3) & 1);
#pragma unroll 1
            for (int e0 = 0; e0 < 128; e0 += 8) {
                if ((e0 & 31) == 0 && e0) __syncthreads();
                u32x4 ur[8][2];
#pragma unroll
                for (int k = 0; k < 8; ++k) { const unsigned id = EXI[tl * 128 + e0 + k]; const unsigned char* row = U8 + (size_t)id * 2048 + 16 * ln;
                    ur[k][0] = *(const u32x4*)row; ur[k][1] = *(const u32x4*)(row + 1024); }
                const unsigned ido = EXI[tl * 128 + e0 + eo]; const float sco = US[ido], gto = EXG[tl * 128 + e0 + eo];
                float d[8];
#pragma unroll
                for (int k = 0; k < 8; ++k) { f32x2 s2 = (f32x2){0.f, 0.f};
#pragma unroll
                    for (int c = 0; c < 2; ++c)
#pragma unroll
                        for (int e = 0; e < 4; ++e) { const f32x2 lo = __builtin_amdgcn_cvt_pk_f32_fp8(ur[k][c][e], false), hi = __builtin_amdgcn_cvt_pk_f32_fp8(ur[k][c][e], true);
                            s2 += lo * xp[8 * c + 2 * e]; s2 += hi * xp[8 * c + 2 * e + 1]; }
                    d[k] = s2.x + s2.y; }
                float q4[4], q2[2];
#pragma unroll
                for (int k = 0; k < 4; ++k) { const float snd = (ln & 32) ? d[k] : d[k + 4], kp = (ln & 32) ? d[k + 4] : d[k]; q4[k] = kp + __shfl_xor(snd, 32); }
#pragma unroll
                for (int k = 0; k < 2; ++k) { const float snd = (ln & 16) ? q4[k] : q4[k + 2], kp = (ln & 16) ? q4[k + 2] : q4[k]; q2[k] = kp + __shfl_xor(snd, 16); }
                float v = ((ln & 8) ? q2[1] : q2[0]) + __shfl_xor((ln & 8) ? q2[0] : q2[1], 8);
                v += __shfl_xor(v, 4); v += __shfl_xor(v, 2); v += __shfl_xor(v, 1);
                if ((ln & 7) == 0) CO[e0 + eo] = gelu_tanh(v * sco) * gto;
            }
#pragma unroll
            for (int i = 0; i < 16; ++i) { xp[i] = xp[i] * ALPHA; asm volatile("" : "+v"(xp[i])); }
        }
        __syncthreads();
#pragma unroll 1
        for (int e0 = 0; e0 < 128; e0 += PB) {
            if ((e0 & 31) == 0 && e0) __syncthreads();
            u32x4 vr[PB][2]; float cf[PB];
#pragma unroll
            for (int k = 0; k < PB; ++k) { const unsigned id = EXI[tl * 128 + e0 + k]; const unsigned char* row = V8 + (size_t)id * 2048 + 16 * ln;
                vr[k][0] = *(const u32x4*)row; vr[k][1] = *(const u32x4*)(row + 1024); cf[k] = VS[id] * CO[e0 + k]; }
#pragma unroll
            for (int k = 0; k < PB; ++k)
#pragma unroll
                for (int c = 0; c < 2; ++c)
#pragma unroll
                    for (int e = 0; e < 4; ++e) { const f32x2 lo = __builtin_amdgcn_cvt_pk_f32_fp8(vr[k][c][e], false), hi = __builtin_amdgcn_cvt_pk_f32_fp8(vr[k][c][e], true);
                        const f32x2 c2 = (f32x2){cf[k], cf[k]}; xp[8 * c + 2 * e] += c2 * lo; xp[8 * c + 2 * e + 1] += c2 * hi; }
        }
        float acc[32];
#pragma unroll
        for (int i = 0; i < 16; ++i) { acc[2 * i] = xp[i].x; acc[2 * i + 1] = xp[i].y; }
        ln_store<16>(acc, gam, bet, outf + (size_t)t * DM, outb ? outb + (size_t)t * DM : nullptr, ln);
        __builtin_amdgcn_wave_barrier();
    }
    __syncthreads();
}

DI void peer_row_fp8_cvt(float (&v)[32], unsigned char* __restrict__ dst, float* __restrict__ inv_scale, int row, int lane) {
    float m = 0.f;
#pragma unroll
    for (int i = 0; i < 32; ++i) m = fmaxf(m, fabsf(v[i]));
    m = wave_max(m);
    int ex = 0; if (m > 0.f) ex = (int)floorf(log2f(448.0f / m));
    ex = ex > 100 ? 100 : (ex < -100 ? -100 : ex);
    float sc = ldexpf(1.0f, ex); if (m * sc > 448.0f) { sc *= 0.5f; ex -= 1; }
#pragma unroll
    for (int c = 0; c < 2; ++c) { u32x4 w;
#pragma unroll
        for (int e = 0; e < 4; ++e) { unsigned x = 0u; x = __builtin_amdgcn_cvt_pk_fp8_f32(v[16 * c + 4 * e] * sc, v[16 * c + 4 * e + 1] * sc, x, false);
            x = __builtin_amdgcn_cvt_pk_fp8_f32(v[16 * c + 4 * e + 2] * sc, v[16 * c + 4 * e + 3] * sc, x, true); w[e] = x; }
        *(u32x4*)(dst + (size_t)row * 2048 + 1024 * c + 16 * lane) = w; }
    if (lane == 0) inv_scale[row] = ldexpf(1.0f, -ex);
}
DI void peer_rows_fp8(const float* __restrict__ src, unsigned char* __restrict__ dst, float* __restrict__ inv_scale, int row0, int lane) {
    float va[32], vb[32];
    load_row32<16>(src + (size_t)row0 * DM, va, lane); load_row32<16>(src + (size_t)(row0 + 1) * DM, vb, lane);
    peer_row_fp8_cvt(va, dst, inv_scale, row0, lane); peer_row_fp8_cvt(vb, dst, inv_scale, row0 + 1, lane);
}

template <int MASK>
DI void prologue_a(LAS unsigned char* lds, const int wid_s_) {
    {
        PHASE_ARGS(p, tid)
        if (MASK & 1) for (int it = bid; it < NL * TC_PER_LAYER; it += G) tconv_dispatch(p, it, (LAS float*)lds, tid);
        if (MASK & 1) for (int i = gtid; i < NL * 16 * 2048; i += gthreads) { const int l = i >> 15, j = (i >> 11) & 15, k = i & 2047; const float wv = p.in[I_WIN][((size_t)l * DM + k) * NIN + 4096 + j]; ((float*)(ws + O_WGT))[i] = wv; ((bf16_t*)(ws + O_WGB))[i] = (bf16_t)(pk_bf16(wv, 0.f) & 0xffffu); }
        if (MASK & 2) for (int it = bid; it < 1024; it += G) ws_item(p, it, tid);
        if (MASK & 4) for (int it = bid; it < NL * 64; it += G) s5_prep_item(p, it, lds, tid);
        if (MASK & 8) for (int it = gwave; it < NL * 8192; it += gwaves) hid2_item(p, it, lane);
        if (MASK & 8) for (int k = gtid; k < FN; k += gthreads) { float s, c; sincospif(-2.0f * (float)k / 16384.0f, &s, &c); ((cf2*)(ws + O_TW))[k] = mk2(c, s); }
        if (MASK & 8) for (int i = gtid; i < T * DM / 8; i += gthreads) { const f32x4 a = *(const f32x4*)(p.in[I_X] + (size_t)i * 8), b = *(const f32x4*)(p.in[I_X] + (size_t)i * 8 + 4);
            *(u32x4*)((bf16_t*)(ws + O_XB) + (size_t)i * 8) = (u32x4){pk_bf16(a[0], a[1]), pk_bf16(a[2], a[3]), pk_bf16(b[0], b[1]), pk_bf16(b[2], b[3])}; }
    }
}

template <int l>
DI void layer_body(LAS unsigned char* lds, const int wid_s_) {
#pragma unroll 1
        for (int rep_ = 0; rep_ < R_INP; ++rep_)
        {
        {
            PHASE_ARGS(p, tid)
            pg8::StaticOrder S1; S1.init(T, 10240, G, bid);
            pg8::gemm_phase(lds, pg8::Gemm{(const bf16_t*)(ws + O_XB), (const bf16_t*)(ws + O_WIN1) + (size_t)l * 10240 * 2048, T, 10240, 2048}, S1,
                            pg8::EpiIn1{(bf16_t*)(ws + O_Q), (bf16_t*)(ws + O_K), (bf16_t*)(ws + O_O), (bf16_t*)(ws + O_G), (bf16_t*)(ws + O_SU)}, tid);
        }
        {
            PHASE_ARGS(p, tid)
            pg8::StaticOrder S2; S2.init(4096, T, G, bid);
            pg8::gemm_phase(lds, pg8::Gemm{(const bf16_t*)(ws + O_WIN2) + (size_t)l * 4096 * 2048, (const bf16_t*)(ws + O_XB), 4096, T, 2048}, S2,
                            pg8::EpiIn2{(bf16_t*)(ws + O_VT), (bf16_t*)(ws + O_HPT)}, tid);
        }
        {
            PHASE_ARGS(p, tid)
            __syncthreads();
            LAS float* part = (LAS float*)lds;
            const int fr = lane & 15, fq = lane >> 4, tile = 2 * bid + (wid >> 2), kq = wid & 3;
            if (tile < T / 16) {
                const bf16_t* xa = (const bf16_t*)(ws + O_XB) + (size_t)(16 * tile + fr) * DM + 512 * kq + 8 * fq;
                const bf16_t* wb = (const bf16_t*)(ws + O_WGB) + ((size_t)l * 16 + fr) * 2048 + 512 * kq + 8 * fq;
                f32x4 acc = (f32x4){0.f, 0.f, 0.f, 0.f};
#pragma unroll
                for (int ks = 0; ks < 16; ++ks) acc = __builtin_amdgcn_mfma_f32_16x16x32_bf16(*(const bf16x8*)(xa + 32 * ks), *(const bf16x8*)(wb + 32 * ks), acc, 0, 0, 0);
#pragma unroll
                for (int j = 0; j < 4; ++j) part[(wid * 16 + 4 * fq + j) * 16 + fr] = acc[j];
            }
            __syncthreads();
            if (kq == 0 && tile < T / 16) {
#pragma unroll
                for (int j = 0; j < 4; ++j) { const int o = ((4 * fq + j) * 16 + fr); const int w0 = wid * 256;
                    ((float*)(ws + O_MG))[(size_t)(16 * tile + 4 * fq + j) * 16 + fr] = (part[w0 + o] + part[w0 + 256 + o]) + (part[w0 + 512 + o] + part[w0 + 768 + o]); }
            }
            __syncthreads();
        }
        }
        GRID_BARRIER();
#pragma unroll 1
        for (int rep_ = 0; rep_ < R_LOC; ++rep_)
        {
#pragma unroll 1
        for (int r2_ = 0; r2_ < R_LA; ++r2_)
        { PHASE_ARGS(p, tid) for (int it = bid; it < 512; it += G) mlstm_passA(p, l, it, lds, tid); }
#pragma unroll 1
        for (int r2_ = 0; r2_ < R_LH; ++r2_)
        { PHASE_ARGS(p, tid) for (int it = bid; it < 512; it += G) hyena_item(p, l, it, lds, tid); }
#pragma unroll 1
        for (int r2_ = 0; r2_ < R_LS; ++r2_)
        { PHASE_ARGS(p, tid) for (int it = bid; it < 512; it += G) s5_mm<0>(p, l, it, tid); }
        }
        GRID_BARRIER();
#pragma unroll 1
        for (int rep_ = 0; rep_ < R_SCAN; ++rep_)
        {
            PHASE_ARGS(p, tid)
            for (int it = bid; it < 2048; it += G) yh_transpose_item(p, it, lds, tid);
            mlstm_passB(p, gtid, gthreads, bid, tid);
            const float* pu = p.in[I_PU] + (size_t)l * 16384 * DM; const float* pv = p.in[I_PV] + (size_t)l * 16384 * DM;
            for (int bb = bid; bb < 256; bb += G) {
                if (wid == 0) { if (lane < 32) s5_scan(p, l, bb * 32 + lane); }
                else for (int r2 = bb * 64 + wid - 1; r2 < bb * 64 + 64; r2 += 7) {
                    if (r2 < 8192) peer_rows_fp8(pu, ws + O_U16, (float*)(ws + O_U16 + (size_t)16384 * 2048), 2 * r2, lane);
                    else peer_rows_fp8(pv, ws + O_V16, (float*)(ws + O_V16 + (size_t)16384 * 2048), 2 * (r2 - 8192), lane);
                }
            }
        }
        GRID_BARRIER();
#pragma unroll 1
        for (int rep_ = 0; rep_ < R_OUT; ++rep_)
        {
#pragma unroll 1
        for (int r2_ = 0; r2_ < R_OM; ++r2_)
        { PHASE_ARGS(p, tid) for (int it = bid; it < 512; it += G) mlstm_passC(p, l, it, lds, tid); }
#pragma unroll 1
        for (int r2_ = 0; r2_ < R_OS; ++r2_)
        { PHASE_ARGS(p, tid) for (int it = bid; it < 512; it += G) s5_mm<1>(p, l, it, tid); }
        }
        GRID_BARRIER();
#pragma unroll 1
        for (int rep_ = 0; rep_ < R_FIN; ++rep_)
        { PHASE_ARGS(p, tid) for (int t = gwave; t < T; t += gwaves) mlstm_final(p, l, t, lane); }
        GRID_BARRIER();
        {
            PHASE_ARGS(p, tid)
            pg8::BranchOrder Sb; Sb.base.init(T, 2048, G, bid);
            Sb.A0 = (const bf16_t*)(ws + O_HN); Sb.A1 = (const bf16_t*)(ws + O_YH); Sb.A2 = (const bf16_t*)(ws + O_YS);
            Sb.B0 = (const bf16_t*)(ws + O_WA) + (size_t)l * 2048 * 1024; Sb.B1 = (const bf16_t*)(ws + O_WB) + (size_t)l * 2048 * 1024; Sb.B2 = (const bf16_t*)(ws + O_WC) + (size_t)l * 4096 * 1024;
            pg8::gemm_phase(lds, pg8::Gemm{Sb.A0, Sb.B0, T, 2048, 1024}, Sb,
                            pg8::EpiBranchAll{(const bf16_t*)(ws + O_G), (bf16_t*)(ws + O_MRG), (bf16_t*)(ws + O_MRG) + (size_t)T * DM, (bf16_t*)(ws + O_MRGB)}, tid);
        }
        GRID_BARRIER();
#pragma unroll 1
        for (int rep_ = 0; rep_ < R_WOUT; ++rep_)
        {
            PHASE_ARGS(p, tid)
            const float* xcur = l == 0 ? p.in[I_X] : (const float*)(ws + O_XF);
            pg8::StaticOrder So; So.init(T, 2048, G, bid);
            pg8::gemm_phase(lds, pg8::Gemm{(const bf16_t*)(ws + O_MRGB), (const bf16_t*)(ws + O_WO) + (size_t)l * 2048 * 2048, T, 2048, 2048}, So, pg8::EpiWout{xcur, (float*)(ws + O_Y1), (bf16_t*)(ws + O_Y1B), (float*)(ws + O_STAT)}, tid);
        }
        GRID_BARRIER();
#pragma unroll 1
        for (int rep_ = 0; rep_ < R_SC; ++rep_)
        {
            PHASE_ARGS(p, tid)
            pg8::StaticOrder Ss; Ss.init(2048, T, G, bid);
            LAS float* MS = (LAS float*)(lds + 131072);
            { pg8::Unit u0; __syncthreads();
              if (Ss.next(0, u0) && tid < 256) { const float* st = (const float*)(ws + O_STAT) + (size_t)(u0.pn * 256 + tid) * 64; float s1 = 0.f, s2 = 0.f;
#pragma unroll
                  for (int i = 0; i < 16; ++i) { const f32x4 v = *(const f32x4*)(st + 4 * i); s1 += v[0] + v[2]; s2 += v[1] + v[3]; }
                  const float mu = s1 * (1.0f / 2048.0f), var = fmaxf(s2 * (1.0f / 2048.0f) - mu * mu, 0.f);
                  MS[2 * tid] = mu; MS[2 * tid + 1] = rsqrtf(var + LN_EPS); }
              __syncthreads(); }
            pg8::gemm_phase(lds, pg8::Gemm{(const bf16_t*)(ws + O_WS) + (size_t)l * 2048 * 2048, (const bf16_t*)(ws + O_Y1B), 2048, T, 2048}, Ss,
                            pg8::EpiScore{(bf16_t*)(ws + O_SCT), (const float*)(ws + O_C1) + l * 2048, (const float*)(ws + O_C2) + l * 2048, MS}, tid);
        }
        GRID_BARRIER();
#pragma unroll 1
        for (int rep_ = 0; rep_ < R_PEER; ++rep_)
        {
            PHASE_ARGS(p, tid)
            float* outf = l == NL - 1 ? p.out : (float*)(ws + O_XF); bf16_t* outb = l == NL - 1 ? nullptr : (bf16_t*)(ws + O_XB);
            for (int it = bid; it < T / 32; it += G) peer_item(p, l, it, p.in[I_L2G] + l * DM, p.in[I_L2B] + l * DM, outf, outb, lds, tid);
        }
        if (l < NL - 1) GRID_BARRIER();
    }

__global__ void __launch_bounds__(512, 2) mega(Params p_unused) {
    extern __shared__ __attribute__((aligned(16))) unsigned char smem[];
    LAS unsigned char* lds = (LAS unsigned char*)smem;
    const int wid_s_ = __builtin_amdgcn_readfirstlane((int)threadIdx.x >> 6);
    {
        volatile LAS unsigned* xbw = (volatile LAS unsigned*)(lds + LDS_BYTES - 16);
        if (threadIdx.x == 0) { xbw[0] = 0u; xbw[1] = 0u; xbw[2] = 0u; xbw[3] = 0u; }
        __syncthreads();
        PHASE_ARGS(p, tid) xcd_barrier_post((unsigned*)(p.ws + O_BAR));
    }

    prologue_a<15>(lds, wid_s_);
#ifdef PRO_DUP_MASK
    prologue_a<PRO_DUP_MASK>(lds, wid_s_);
#endif
    GRID_BARRIER();
    {
        PHASE_ARGS(p, tid)
        for (int it = bid; it < NL * 64; it += G) ftap_item(p, it, tid);
    }
    {
        PHASE_ARGS(p, tid)
        for (int i = gtid; i < NL * 2048; i += gthreads) {
            const float* a1 = (const float*)(ws + O_C1P) + (size_t)i * 128; const float* a2 = (const float*)(ws + O_C2P) + (size_t)i * 128; float s1 = 0.f, s2 = 0.f;
#pragma unroll 4
            for (int k = 0; k < 32; ++k) { const f32x4 u = *(const f32x4*)(a1 + 4 * k), v = *(const f32x4*)(a2 + 4 * k); s1 += (u[0] + u[1]) + (u[2] + u[3]); s2 += (v[0] + v[1]) + (v[2] + v[3]); }
            ((float*)(ws + O_C1))[i] = s1; ((float*)(ws + O_C2))[i] = s2; }
    }
    GRID_BARRIER();
#pragma unroll 1
    for (int rep_ = 0; rep_ < R_PROB; ++rep_)
    {
        PHASE_ARGS(p, tid)
        for (int it = bid; it < NL * 512; it += G) filt_item(p, it, lds, tid);
    }
    GRID_BARRIER();

    layer_body<0>(lds, wid_s_);
    layer_body<1>(lds, wid_s_);
    layer_body<2>(lds, wid_s_);
    layer_body<3>(lds, wid_s_);
}

extern "C" void kernel_launch(void* const* d_in, const int* in_sizes, int n_in, void* d_out, int out_size, void* d_ws, size_t ws_size, hipStream_t stream) {
    static int grid = 0;
    if (!grid) {
        int dev = 0, cus = 0, per_cu = 0;
        hipGetDevice(&dev);
        hipDeviceGetAttribute(&cus, hipDeviceAttributeMultiprocessorCount, dev);
        hipFuncSetAttribute((const void*)mega, hipFuncAttributeMaxDynamicSharedMemorySize, LDS_BYTES);
        hipOccupancyMaxActiveBlocksPerMultiprocessor(&per_cu, mega, NTHREADS, LDS_BYTES);
        if (per_cu < 1) { fprintf(stderr, "mega: occupancy query says 0 blocks per CU\n"); per_cu = 1; }
        grid = cus;
    }
    if (ws_size < WS_NEED || n_in < 34) { fprintf(stderr, "kernel_launch: workspace too small (%zu < %zu) or inputs missing\n", ws_size, (size_t)WS_NEED); return; }
    hipMemsetAsync((unsigned char*)d_ws + O_BAR, 0, 16384, stream);
    Params p{};
    for (int i = 0; i < 34; ++i) p.in[i] = (const float*)d_in[i];
    p.out = (float*)d_out; p.ws = (unsigned char*)d_ws;
    hipLaunchKernelGGL(mega, dim3(grid), dim3(NTHREADS), LDS_BYTES, stream, p);
}
```
